# Optimizing an MI355X kernel written in HIP

```python
import jax, jax.numpy as jnp
from jax import lax
import numpy as np

D_MODEL = 2048
BATCH = 16
SEQ = 2048
DEPTH = 4

N_MIXERS = 3
RMS_EPS = 1e-6

RWKV_HEAD_DIM = 64
RWKV_HEADS = D_MODEL // RWKV_HEAD_DIM
DECAY_LORA = 96
AAA_LORA = 96
MV_LORA = 64
RWKV_LN_EPS = 64e-5

ATT_HEAD_DIM = 128
DILATED_CONFIG = ((128, 1), (512, 4), (2048, 16))
ATT_GROUPS = len(DILATED_CONFIG)
ATT_HEADS_PER_GROUP = D_MODEL // (2 * ATT_HEAD_DIM)
ATT_BRANCH = ATT_HEADS_PER_GROUP * ATT_HEAD_DIM
ATT_QKV = 3 * ATT_GROUPS * ATT_BRANCH
ATT_BLOCK = 128
ROPE_THETA = 500000.0
ROPE_DIM = ATT_HEAD_DIM // 4

POOL_WINDOWS = (2, 4, 8, 16)
POOL_WIDTH = D_MODEL
POOL_GROUP = POOL_WIDTH // len(POOL_WINDOWS)

kernel_name = "hybrid_rwkv7_dilated_attn_pool_trunk"


def _rms_norm(x, w):
    xf = x.astype(jnp.float32)
    y = xf * lax.rsqrt(jnp.mean(xf * xf, axis=-1, keepdims=True) + RMS_EPS)
    return (y * w.astype(jnp.float32)).astype(x.dtype)


def _rwkv7_scan(r, w, k, v, a, b):
    B, S, H, N = r.shape

    def step(state, inp):
        r_t, w_t, k_t, v_t, a_t, b_t = inp
        sa = jnp.einsum('bhij,bhj->bhi', state, a_t)
        state = (state * w_t[:, :, None, :] + sa[..., None] * b_t[:, :, None, :]
                 + v_t[..., None] * k_t[:, :, None, :])
        y_t = jnp.einsum('bhij,bhj->bhi', state, r_t)
        return state, y_t

    xs = tuple(jnp.moveaxis(t, 1, 0) for t in (r, w, k, v, a, b))
    init = jnp.zeros((B, H, N, N), jnp.float32)
    _, ys = lax.scan(step, init, xs)
    return jnp.moveaxis(ys, 0, 1)


def _head_group_norm(y, w, b):
    B, S, H, N = y.shape
    mu = jnp.mean(y, axis=-1, keepdims=True)
    yc = y - mu
    var = jnp.mean(yc * yc, axis=-1, keepdims=True)
    yn = (yc * lax.rsqrt(var + RWKV_LN_EPS)).reshape(B, S, H * N)
    return yn * w.astype(jnp.float32) + b.astype(jnp.float32)


def _rwkv7_mixer(h, mu, w_in, w0, w1, w2, a0, a1, a2, k_k, k_a, r_k, lnx_w, lnx_b,
                 w_out, v_first, vres):
    B, S, D = h.shape
    H, N = RWKV_HEADS, RWKV_HEAD_DIM
    heads = lambda t: t.reshape(B, S, H, N)
    xx = jnp.pad(h, ((0, 0), (1, 0), (0, 0)))[:, :S] - h
    r, k, v, g = [(h + xx * mu[j]) @ w_in[j] for j in range(4)]
    xw = h + xx * mu[4]
    xa = h + xx * mu[5]
    w_log = -jax.nn.softplus(-(w0 + jnp.tanh(xw @ w1) @ w2).astype(jnp.float32)) - 0.5
    decay = jnp.exp(-jnp.exp(w_log))
    if vres is None:
        v_first = v
    else:
        v0, v1, v2 = vres
        xv = h + xx * mu[2]
        v = v + (v_first - v) * jax.nn.sigmoid(v0 + (xv @ v1) @ v2)
    a = jax.nn.sigmoid(a0 + (xa @ a1) @ a2)
    kk = heads(k * k_k).astype(jnp.float32)
    kk = kk / jnp.maximum(jnp.sqrt(jnp.sum(kk * kk, axis=-1, keepdims=True)), 1e-12)
    k = k * (1 + (a - 1) * k_a)
    af = heads(a).astype(jnp.float32)
    vf = heads(v).astype(jnp.float32)
    y = _rwkv7_scan(heads(r).astype(jnp.float32), heads(decay), heads(k).astype(jnp.float32),
                    vf, -kk, kk * af)
    y = _head_group_norm(y, lnx_w, lnx_b)
    bonus = jnp.sum(heads(r * k).astype(jnp.float32) * r_k.astype(jnp.float32),
                    axis=-1, keepdims=True) * vf
    y = (y + bonus.reshape(B, S, D)).astype(h.dtype) * jax.nn.silu(g)
    return y @ w_out, v_first


def _rope_tables(positions):
    inv_freq = ROPE_THETA ** (-jnp.arange(0, ROPE_DIM, 2, dtype=jnp.float32) / ROPE_DIM)
    ang = positions.astype(jnp.float32)[..., None] * inv_freq
    return jnp.cos(ang), jnp.sin(ang)


def _apply_partial_rope(x, cos, sin):
    half = ROPE_DIM // 2
    c = cos[:, :, None, None, :].astype(x.dtype)
    s = sin[:, :, None, None, :].astype(x.dtype)
    x1 = x[..., :half]
    x2 = x[..., half:ROPE_DIM]
    return jnp.concatenate([x1 * c - x2 * s, x1 * s + x2 * c, x[..., ROPE_DIM:]], axis=-1)


def _dilated_window_attention(q, k, v, window, dilation):
    B, S, H, Dh = q.shape
    steps = window // dilation
    L = S // dilation
    nblk = -(-L // ATT_BLOCK)
    pad = nblk * ATT_BLOCK - L

    def gather(t):
        t = t.reshape(B, L, dilation, H, Dh).transpose(0, 2, 3, 1, 4)
        t = jnp.pad(t, ((0, 0), (0, 0), (0, 0), (0, pad), (0, 0)))
        return t.reshape(B, dilation, H, nblk, ATT_BLOCK, Dh)

    def with_prev(t):
        prev = jnp.pad(t[:, :, :, :-1], ((0, 0), (0, 0), (0, 0), (1, 0), (0, 0), (0, 0)))
        return jnp.concatenate([prev, t], axis=4)

    qb = gather(q)
    kc = with_prev(gather(k))
    vc = with_prev(gather(v))
    qi = jnp.arange(ATT_BLOCK)[:, None]
    kj = jnp.arange(2 * ATT_BLOCK)[None, :]
    dist = ATT_BLOCK + qi - kj
    key_idx = (jnp.arange(nblk)[:, None, None] - 1) * ATT_BLOCK + kj[None]
    mask = (dist >= 0)[None] & (dist <= steps)[None] & (key_idx >= 0)
    s = jnp.einsum('bghnqe,bghnke->bghnqk', qb, kc).astype(jnp.float32) * (Dh ** -0.5)
    s = jnp.where(mask, s, -jnp.inf)
    m = jnp.max(s, axis=-1, keepdims=True)
    p = jnp.exp(s - m)
    l = jnp.sum(p, axis=-1, keepdims=True)
    o = jnp.einsum('bghnqk,bghnke->bghnqe', p, vc.astype(jnp.float32)) / l
    lse = (m + jnp.log(l))[..., 0]
    o = o.reshape(B, dilation, H, nblk * ATT_BLOCK, Dh)[:, :, :, :L]
    o = o.transpose(0, 3, 1, 2, 4).reshape(B, S, H, Dh)
    lse = lse.reshape(B, dilation, H, nblk * ATT_BLOCK)[:, :, :, :L]
    lse = lse.transpose(0, 3, 1, 2).reshape(B, S, H)
    return o, lse


def _dilated_attn_mixer(h, positions, w_in, qn_w, kn_w, w_out):
    B, S, _ = h.shape
    proj = h @ w_in
    qkv = proj[..., :ATT_QKV].reshape(B, S, 3, ATT_GROUPS, ATT_HEADS_PER_GROUP, ATT_HEAD_DIM)
    gate = proj[..., ATT_QKV:]
    cos, sin = _rope_tables(positions)
    q = _apply_partial_rope(_rms_norm(qkv[:, :, 0], qn_w[:, None, :]), cos, sin)
    k = _apply_partial_rope(_rms_norm(qkv[:, :, 1], kn_w[:, None, :]), cos, sin)
    v = qkv[:, :, 2]
    outs, lses = [], []
    for gi, (window, dilation) in enumerate(DILATED_CONFIG):
        o_g, lse_g = _dilated_window_attention(q[:, :, gi], k[:, :, gi], v[:, :, gi], window, dilation)
        outs.append(o_g)
        lses.append(lse_g)
    wts = jax.nn.softmax(jnp.stack(lses, axis=0), axis=0)
    o = jnp.sum(wts[..., None] * jnp.stack(outs, axis=0), axis=0)
    o = o.astype(h.dtype).reshape(B, S, ATT_BRANCH)
    return (o * jax.nn.silu(gate)) @ w_out


def _pool_mixer(h, w_in, w_grp, scale, w_out):
    B, S, _ = h.shape
    u, gate = jnp.split(h @ w_in, 2, axis=-1)
    c = jnp.pad(jnp.cumsum(u.astype(jnp.float32), axis=1), ((0, 0), (1, 0), (0, 0)))
    t = jnp.arange(S)
    pooled = []
    for j, win in enumerate(POOL_WINDOWS):
        cg = c[..., j * POOL_GROUP:(j + 1) * POOL_GROUP]
        lower = jnp.pad(cg[:, :S + 1 - win], ((0, 0), (win - 1, 0), (0, 0)))
        cnt = jnp.minimum(t + 1, win).astype(jnp.float32)[None, :, None]
        pooled.append((cg[:, 1:] - lower) / cnt)
    pooled = jnp.stack(pooled, axis=2).astype(h.dtype)
    diff = pooled - u.reshape(B, S, len(POOL_WINDOWS), POOL_GROUP)
    y = jnp.einsum('bsgc,gce->bsge', diff, w_grp).reshape(B, S, POOL_WIDTH) * scale
    return (y * jax.nn.silu(gate)) @ w_out


def setup_inputs(seed: int = 0) -> dict:
    key = jax.random.key(seed)
    ks = iter(jax.random.split(key, 40))
    f32 = jnp.float32
    n_a = (DEPTH + 2) // 3
    n_b = (DEPTH + 1) // 3
    n_c = DEPTH // 3
    D, H, N = D_MODEL, RWKV_HEADS, RWKV_HEAD_DIM

    def nrm(shape, scale):
        return jax.random.normal(next(ks), shape, f32) * scale

    x = jax.random.normal(next(ks), (BATCH, SEQ, D), f32)
    offset = jax.random.randint(next(ks), (BATCH, 1), 0, 4096, dtype=jnp.int32)
    positions = offset + jnp.arange(SEQ, dtype=jnp.int32)[None, :]
    norm_w = 1.0 + nrm((DEPTH, D), 0.1)
    lin = jnp.linspace(0.0, 1.0, D, dtype=f32)
    inp = {
        'x': x,
        'positions': positions,
        'norm_w': norm_w,
        'a_mu': jax.random.uniform(next(ks), (n_a, 6, D), f32),
        'a_w_in': nrm((n_a, 4, D, D), D ** -0.5),
        'a_w0': (-6.5 + 5.0 * lin ** 1.5)[None, :] + nrm((n_a, D), 0.1),
        'a_w1': nrm((n_a, D, DECAY_LORA), D ** -0.5),
        'a_w2': nrm((n_a, DECAY_LORA, D), 0.1 * DECAY_LORA ** -0.5),
        'a_a0': nrm((n_a, D), 0.3),
        'a_a1': nrm((n_a, D, AAA_LORA), D ** -0.5),
        'a_a2': nrm((n_a, AAA_LORA, D), 0.3 * AAA_LORA ** -0.5),
        'a_k_k': 0.85 + nrm((n_a, D), 0.05),
        'a_k_a': 1.0 + nrm((n_a, D), 0.05),
        'a_r_k': nrm((n_a, H, N), 0.1),
        'a_lnx_w': 1.0 + nrm((n_a, D), 0.1),
        'a_lnx_b': nrm((n_a, D), 0.02),
        'a_v0': 1.0 + nrm((n_a - 1, D), 0.1),
        'a_v1': nrm((n_a - 1, D, MV_LORA), D ** -0.5),
        'a_v2': nrm((n_a - 1, MV_LORA, D), 0.3 * MV_LORA ** -0.5),
        'a_w_out': nrm((n_a, D, D), 0.5 * D ** -0.5),
        'b_w_in': nrm((n_b, D, ATT_QKV + ATT_BRANCH), D ** -0.5),
        'b_qn_w': 1.0 + nrm((n_b, ATT_GROUPS, ATT_HEAD_DIM), 0.1),
        'b_kn_w': 1.0 + nrm((n_b, ATT_GROUPS, ATT_HEAD_DIM), 0.1),
        'b_w_out': nrm((n_b, ATT_BRANCH, D), 0.5 * ATT_BRANCH ** -0.5),
        'c_w_in': nrm((n_c, D, 2 * POOL_WIDTH), D ** -0.5),
        'c_w_grp': nrm((n_c, len(POOL_WINDOWS), POOL_GROUP, POOL_GROUP), POOL_GROUP ** -0.5),
        'c_scale': 1.0 + nrm((n_c, POOL_WIDTH), 0.1),
        'c_w_out': nrm((n_c, POOL_WIDTH, D), 0.5 * POOL_WIDTH ** -0.5),
    }
    return inp


def reference(x, positions, norm_w, a_mu, a_w_in, a_w0, a_w1, a_w2, a_a0, a_a1, a_a2,
              a_k_k, a_k_a, a_r_k, a_lnx_w, a_lnx_b, a_v0, a_v1, a_v2, a_w_out,
              b_w_in, b_qn_w, b_kn_w, b_w_out, c_w_in, c_w_grp, c_scale, c_w_out):
    ia = ib = ic = 0
    v_first = None
    for i in range(DEPTH):
        h = _rms_norm(x, norm_w[i])
        kind = i % N_MIXERS
        if kind == 0:
            vres = None if ia == 0 else (a_v0[ia - 1], a_v1[ia - 1], a_v2[ia - 1])
            y, vf = _rwkv7_mixer(h, a_mu[ia], a_w_in[ia], a_w0[ia], a_w1[ia], a_w2[ia],
                                 a_a0[ia], a_a1[ia], a_a2[ia], a_k_k[ia], a_k_a[ia], a_r_k[ia],
                                 a_lnx_w[ia], a_lnx_b[ia], a_w_out[ia], v_first, vres)
            if v_first is None:
                v_first = vf
            ia += 1
        elif kind == 1:
            y = _dilated_attn_mixer(h, positions, b_w_in[ib], b_qn_w[ib], b_kn_w[ib], b_w_out[ib])
            ib += 1
        else:
            y = _pool_mixer(h, c_w_in[ic], c_w_grp[ic], c_scale[ic], c_w_out[ic])
            ic += 1
        x = x + y
    return x
```

```cpp
#include <hip/hip_runtime.h>
#include <hip/hip_cooperative_groups.h>
#include <cstdio>
namespace cg = cooperative_groups;

#ifndef MK_MULTI
#define MK_MULTI 0
#endif

#define LAS __attribute__((address_space(3)))
typedef unsigned short bf16_t;
typedef short bf16x8 __attribute__((ext_vector_type(8)));
typedef float f32x4 __attribute__((ext_vector_type(4)));
typedef float f32x2 __attribute__((ext_vector_type(2)));
typedef unsigned u32x4 __attribute__((ext_vector_type(4)));
typedef unsigned u32x2 __attribute__((ext_vector_type(2)));
typedef unsigned short u16x4 __attribute__((ext_vector_type(4)));

constexpr int Dm = 2048, NB = 16, SEQ = 2048, T = NB * SEQ;
constexpr float RMS_EPS = 1e-6f, LN_EPS = 64e-5f;
constexpr int NTHR = 512, NWAVE = 8;
constexpr int LDS_BYTES = 128 * 1024;
constexpr size_t MiB = 1024 * 1024;
constexpr size_t WS_W = 0;
constexpr size_t WS_LORA = 64 * MiB;
constexpr size_t WS_COS = 80 * MiB;
constexpr size_t WS_SIN = 82 * MiB;
constexpr size_t WS_LSE = 84 * MiB;
constexpr size_t WS_BAR = 88 * MiB;
constexpr size_t WS_VF = 128 * MiB;
constexpr size_t WS_B1 = 256 * MiB, WS_B2 = 384 * MiB, WS_B3 = 512 * MiB, WS_B4 = 640 * MiB, WS_M0 = 768 * MiB, WS_M1 = 896 * MiB;
constexpr size_t WS_END = 1024 * MiB;

struct Params {
    const float* in[28];
    const int* positions;
    float* out;
    unsigned char* ws;
    int ph_lo, ph_hi;
};

__device__ __forceinline__ unsigned pk2(float lo, float hi) { unsigned r; asm volatile("v_cvt_pk_bf16_f32 %0, %1, %2" : "=v"(r) : "v"(lo), "v"(hi)); return r; }
__device__ __forceinline__ float bf_lo(unsigned u) { return __uint_as_float(u << 16); }
__device__ __forceinline__ float bf_hi(unsigned u) { return __uint_as_float(u & 0xffff0000u); }
__device__ __forceinline__ unsigned pkh2(float lo, float hi) { typedef _Float16 h2 __attribute__((ext_vector_type(2))); h2 v; v.x = (_Float16)lo; v.y = (_Float16)hi; return __builtin_bit_cast(unsigned, v); }
__device__ __forceinline__ float h_lo(unsigned u) { typedef _Float16 h2 __attribute__((ext_vector_type(2))); h2 v = __builtin_bit_cast(h2, u); return (float)v.x; }
__device__ __forceinline__ float h_hi(unsigned u) { typedef _Float16 h2 __attribute__((ext_vector_type(2))); h2 v = __builtin_bit_cast(h2, u); return (float)v.y; }
__device__ __forceinline__ float wave_sum(float v) {
#pragma unroll
    for (int o = 1; o < 64; o <<= 1) v += __shfl_xor(v, o);
    return v;
}
__device__ __forceinline__ float quad_sum(float v) {
    v += __int_as_float(__builtin_amdgcn_update_dpp(0, __float_as_int(v), 0xB1, 0xF, 0xF, true));
    v += __int_as_float(__builtin_amdgcn_update_dpp(0, __float_as_int(v), 0x4E, 0xF, 0xF, true));
    return v;
}
__device__ __forceinline__ float row16_sum(float v) {
    v = quad_sum(v);
    v += __int_as_float(__builtin_amdgcn_update_dpp(0, __float_as_int(v), 0x124, 0xF, 0xF, true));
    v += __int_as_float(__builtin_amdgcn_update_dpp(0, __float_as_int(v), 0x128, 0xF, 0xF, true));
    return v;
}
__device__ __forceinline__ float sigmoidf_(float x) { return 1.f / (1.f + __expf(-x)); }
__device__ __forceinline__ float siluf_(float x) { return x / (1.f + __expf(-x)); }

constexpr int BM = 256, BK = 64, HALF = 128, HTB = HALF * BK * 2, NXCD = 8, WGM = 8;
__device__ __forceinline__ int lds_byte(int r, int c) { const int st = (r >> 4) * 2 + (c >> 5), rr = r & 15, cc = c & 31, ob = rr * 64 + cc * 2; return st * 1024 + (ob ^ (((ob >> 9) & 1) << 5)); }
__device__ __forceinline__ void stage_rc(int b, int& R, int& C) { const int st = b / 1024, sb = b % 1024, swz = sb ^ (((sb >> 9) & 1) << 5); R = (st >> 1) * 16 + swz / 64; C = (st & 1) * 32 + (swz % 64) / 2; }
__device__ __forceinline__ int perm32(int rho) { const int n = rho >> 4, i = rho & 15; return 8 * (i >> 2) + 4 * n + (i & 3); }
struct Unit { int pm, pn; };
__device__ __forceinline__ bool unit_next(int nM, int nN, int i, Unit& u) {
    const int nwg = nM * nN; const long L = (long)i * gridDim.x + blockIdx.x; if (L >= nwg) return false;
    int wgid = (int)L; { const int q = nwg / NXCD, r = nwg % NXCD, xcd = wgid % NXCD, off = wgid / NXCD; wgid = (xcd < r ? xcd * (q + 1) : r * (q + 1) + (xcd - r) * q) + off; }
    const int nig = WGM * nN, gid = wgid / nig, fm = gid * WGM, gsz = (nM - fm) < WGM ? (nM - fm) : WGM;
    u.pm = fm + ((wgid % nig) % gsz); u.pn = (wgid % nig) / gsz; return true;
}

template <class P>
__device__ __forceinline__ void gemm_phase(int tid, LAS unsigned char* lds, const P& prob) {
    const int wid = __builtin_amdgcn_readfirstlane(tid >> 6), lane = tid & 63, wr = wid >> 2, wc = wid & 3, fr = lane & 15, fq = lane >> 4;
    const int nt = prob.nt;
    unsigned voffA[2], voffB[2];
#pragma unroll
    for (int i = 0; i < 2; ++i) { int R, C; stage_rc(tid * 16 + i * 8192, R, C); const int Rb = P::PERM ? ((R & ~31) + perm32(R & 31)) : R;
        voffA[i] = (unsigned)(R * prob.lda + C) * 2u; voffB[i] = (unsigned)(Rb * prob.ldb + C) * 2u; }
    const size_t kstep = (size_t)(BK * 2);
    const size_t hstepA = (size_t)HALF * prob.lda * 2, hstepB = (size_t)HALF * prob.ldb * 2;
    const unsigned ldsw = (unsigned)wid * 1024u;
    const int aoff = lds_byte(wr * 64 + fr, fq * 8), boff = lds_byte(wc * 32 + fr, fq * 8);
#define G_SA(b, h) (((b) * 2 + (h)) * HTB)
#define G_SB(b, h) ((4 + (b) * 2 + (h)) * HTB)
#define G_STAGE(bufoff, gbase, voff) do { _Pragma("unroll") for (int _i = 0; _i < 2; ++_i) \
        __builtin_amdgcn_global_load_lds((const unsigned*)((const char*)(gbase) + (voff)[_i]), (LAS unsigned*)(lds + (bufoff) + ldsw + _i * 8192), 16, 0, 0); } while (0)
#define G_LDA(dst, b, h) do { _Pragma("unroll") for (int m = 0; m < 4; ++m) _Pragma("unroll") for (int k = 0; k < 2; ++k) dst[m][k] = *(const LAS bf16x8*)(lds + G_SA(b, h) + aoff + m * 2048 + k * 1024); } while (0)
#define G_LDB(dst, b, h) do { _Pragma("unroll") for (int n = 0; n < 2; ++n) _Pragma("unroll") for (int k = 0; k < 2; ++k) dst[n][k] = *(const LAS bf16x8*)(lds + G_SB(b, h) + boff + n * 2048 + k * 1024); } while (0)
#define G_MMA(ai, bj, At, Bt) do { __builtin_amdgcn_s_setprio(1); _Pragma("unroll") for (int m = 0; m < 4; ++m) _Pragma("unroll") for (int n = 0; n < 2; ++n) _Pragma("unroll") for (int k = 0; k < 2; ++k) \
        acc[ai][bj][m][n] = __builtin_amdgcn_mfma_f32_16x16x32_bf16(Bt[n][k], At[m][k], acc[ai][bj][m][n], 0, 0, 0); __builtin_amdgcn_s_setprio(0); } while (0)
#define G_WAIT_V(n) asm volatile("s_waitcnt vmcnt(" #n ")" ::: "memory")
#define G_WAIT_L(n) asm volatile("s_waitcnt lgkmcnt(" #n ")" ::: "memory")
#define G_BAR __builtin_amdgcn_s_barrier()
#define G_SCHED __builtin_amdgcn_sched_barrier(0)
    Unit cur, nxt; int ui = 0;
    if (!unit_next(prob.nM, prob.nN, 0, cur)) return;
    f32x4 acc[2][2][4][2];
    prob.init_acc(acc, cur, wr, wc, fr, fq);
    bf16x8 At[4][2], B0[2][2], B1[2][2];
    const char* cA = prob.a_ptr(cur); const char* cB = prob.b_ptr(cur);
    G_STAGE(G_SB(0, 0), cB, voffB); G_STAGE(G_SA(0, 0), cA, voffA); G_STAGE(G_SB(0, 1), cB + hstepB, voffB); G_STAGE(G_SA(0, 1), cA + hstepA, voffA);
    if (wr == 1) G_BAR;
    G_WAIT_V(4); G_BAR;
    G_STAGE(G_SB(1, 0), cB + kstep, voffB); G_STAGE(G_SA(1, 0), cA + kstep, voffA); G_STAGE(G_SB(1, 1), cB + hstepB + kstep, voffB);
    G_WAIT_V(6); G_BAR;
    for (;;) {
        const bool has_next = unit_next(prob.nM, prob.nN, ui + 1, nxt);
        const char* nA = has_next ? prob.a_ptr(nxt) : cA; const char* nB = has_next ? prob.b_ptr(nxt) : cB;
        for (int t = 0; t < nt; t += 2) {
            const bool last = (t == nt - 2);
            const char* a1 = cA + (size_t)(t + 1) * kstep;
            const char* a2 = last ? nA : cA + (size_t)(t + 2) * kstep; const char* b2 = last ? nB : cB + (size_t)(t + 2) * kstep;
            const char* a3 = a2 + kstep; const char* b3 = b2 + kstep;
            G_LDB(B0, 0, 0); G_SCHED; G_LDA(At, 0, 0); G_STAGE(G_SA(1, 1), a1 + hstepA, voffA);
            G_WAIT_L(8); G_BAR; G_WAIT_L(0); G_MMA(0, 0, At, B0); G_BAR; G_SCHED;
            G_LDB(B1, 0, 1); G_STAGE(G_SB(0, 0), b2, voffB);
            G_BAR; G_WAIT_L(0); G_MMA(0, 1, At, B1); G_BAR;
            G_LDA(At, 0, 1); G_STAGE(G_SA(0, 0), a2, voffA);
            G_BAR; G_WAIT_L(0); G_MMA(1, 0, At, B0); G_BAR; G_SCHED;
            G_STAGE(G_SB(0, 1), b2 + hstepB, voffB);
            G_WAIT_V(6); G_BAR; G_MMA(1, 1, At, B1); G_BAR;
            G_LDB(B0, 1, 0); G_SCHED; G_LDA(At, 1, 0); G_STAGE(G_SA(0, 1), a2 + hstepA, voffA);
            G_WAIT_L(8); G_BAR; G_WAIT_L(0); G_MMA(0, 0, At, B0); G_BAR; G_SCHED;
            G_LDB(B1, 1, 1); G_STAGE(G_SB(1, 0), b3, voffB);
            G_BAR; G_WAIT_L(0); G_MMA(0, 1, At, B1); G_BAR;
            G_LDA(At, 1, 1); G_STAGE(G_SA(1, 0), a3, voffA);
            G_BAR; G_WAIT_L(0); G_MMA(1, 0, At, B0); G_BAR; G_SCHED;
            G_STAGE(G_SB(1, 1), b3 + hstepB, voffB);
            G_WAIT_V(6); G_BAR; G_MMA(1, 1, At, B1); G_BAR;
        }
        prob.epi(acc, cur, wr, wc, fr, fq);
        if (!has_next) break;
        prob.init_acc(acc, nxt, wr, wc, fr, fq);
        cur = nxt; cA = nA; cB = nB; ++ui;
    }
    G_WAIT_V(0);
    if (wr == 0) G_BAR;
    G_BAR;
#undef G_SA
#undef G_SB
#undef G_STAGE
#undef G_LDA
#undef G_LDB
#undef G_MMA
#undef G_WAIT_V
#undef G_WAIT_L
#undef G_BAR
#undef G_SCHED
}

#define EPI_ROWS(u) const int row0 = (u).pm * BM + wr * 64 + fr
#define EPI_FOR_RM _Pragma("unroll") for (int ai = 0; ai < 2; ++ai) _Pragma("unroll") for (int m = 0; m < 4; ++m)

#define PK8(v0, v1) ((u32x4){pk2((v0)[0], (v0)[1]), pk2((v0)[2], (v0)[3]), pk2((v1)[0], (v1)[1]), pk2((v1)[2], (v1)[3])})
struct ProbStoreBf16 {
    static constexpr bool PERM = true;
    int nM, nN, nt, lda, ldb;
    const bf16_t* A; const bf16_t* Bt; bf16_t* O; int ldo;
    __device__ __forceinline__ void init_acc(f32x4 (&acc)[2][2][4][2], const Unit&, int, int, int, int) const {
#pragma unroll
        for (int a = 0; a < 2; ++a)
#pragma unroll
            for (int b = 0; b < 2; ++b)
#pragma unroll
                for (int m = 0; m < 4; ++m)
#pragma unroll
                    for (int n = 0; n < 2; ++n) acc[a][b][m][n] = (f32x4){0.f, 0.f, 0.f, 0.f};
    }
    __device__ __forceinline__ const char* a_ptr(const Unit& u) const { return (const char*)(A + (size_t)u.pm * BM * lda); }
    __device__ __forceinline__ const char* b_ptr(const Unit& u) const { return (const char*)(Bt + (size_t)u.pn * BM * ldb); }
    __device__ __forceinline__ void epi(const f32x4 (&acc)[2][2][4][2], const Unit& u, int wr, int wc, int fr, int fq) const {
        EPI_ROWS(u); const int col0 = u.pn * BM + wc * 32 + 8 * fq;
        EPI_FOR_RM { bf16_t* rowp = O + (size_t)(row0 + ai * HALF + m * 16) * ldo + col0;
#pragma unroll
            for (int bj = 0; bj < 2; ++bj) { const f32x4 v0 = acc[ai][bj][m][0], v1 = acc[ai][bj][m][1];
                u32x4 o; o.x = pk2(v0[0], v0[1]); o.y = pk2(v0[2], v0[3]); o.z = pk2(v1[0], v1[1]); o.w = pk2(v1[2], v1[3]);
                *(u32x4*)(rowp + bj * HALF) = o; } }
    }
};
struct ProbResid {
    static constexpr bool PERM = true;
    int nM, nN, nt, lda, ldb;
    const bf16_t* A; const bf16_t* Bt; const void* xin; void* xout; int in_bf, out_bf;
    __device__ __forceinline__ void init_acc(f32x4 (&acc)[2][2][4][2], const Unit& u, int wr, int wc, int fr, int fq) const {
        EPI_ROWS(u); const int col0 = u.pn * BM + wc * 32 + 8 * fq;
        if (in_bf) {
#pragma unroll
            for (int ai = 0; ai < 2; ++ai)
#pragma unroll
                for (int bj = 0; bj < 2; ++bj)
#pragma unroll
                    for (int m = 0; m < 4; ++m) { const u32x4 r = *(const u32x4*)((const bf16_t*)xin + (size_t)(row0 + ai * HALF + m * 16) * Dm + col0 + bj * HALF);
                        acc[ai][bj][m][0] = (f32x4){bf_lo(r.x), bf_hi(r.x), bf_lo(r.y), bf_hi(r.y)}; acc[ai][bj][m][1] = (f32x4){bf_lo(r.z), bf_hi(r.z), bf_lo(r.w), bf_hi(r.w)}; }
        } else {
#pragma unroll
            for (int ai = 0; ai < 2; ++ai)
#pragma unroll
                for (int bj = 0; bj < 2; ++bj)
#pragma unroll
                    for (int m = 0; m < 4; ++m)
#pragma unroll
                        for (int n = 0; n < 2; ++n) acc[ai][bj][m][n] = *(const f32x4*)((const float*)xin + (size_t)(row0 + ai * HALF + m * 16) * Dm + col0 + bj * HALF + 4 * n);
        }
    }
    __device__ __forceinline__ const char* a_ptr(const Unit& u) const { return (const char*)(A + (size_t)u.pm * BM * lda); }
    __device__ __forceinline__ const char* b_ptr(const Unit& u) const { return (const char*)(Bt + (size_t)u.pn * BM * ldb); }
    __device__ __forceinline__ void epi(const f32x4 (&acc)[2][2][4][2], const Unit& u, int wr, int wc, int fr, int fq) const {
        EPI_ROWS(u); const int col0 = u.pn * BM + wc * 32 + 8 * fq;
        if (out_bf) {
            EPI_FOR_RM { const size_t ro = (size_t)(row0 + ai * HALF + m * 16) * Dm + col0;
#pragma unroll
                for (int bj = 0; bj < 2; ++bj) *(u32x4*)((bf16_t*)xout + ro + bj * HALF) = PK8(acc[ai][bj][m][0], acc[ai][bj][m][1]); }
        } else {
            EPI_FOR_RM { const size_t ro = (size_t)(row0 + ai * HALF + m * 16) * Dm + col0;
#pragma unroll
                for (int bj = 0; bj < 2; ++bj)
#pragma unroll
                    for (int n = 0; n < 2; ++n) *(f32x4*)((float*)xout + ro + bj * HALF + 4 * n) = acc[ai][bj][m][n]; }
        }
    }
};
struct ProbRwkvIn {
    static constexpr bool PERM = true;
    int nM, nN, nt, lda, ldb;
    int round;
    const bf16_t* A0; long dA1, dA2;
    const bf16_t* Wt;
    bf16_t* O0; long dO1, dO2, dO3; bf16_t* lora;
    __device__ __forceinline__ void init_acc(f32x4 (&acc)[2][2][4][2], const Unit&, int, int, int, int) const {
#pragma unroll
        for (int a = 0; a < 2; ++a)
#pragma unroll
            for (int b = 0; b < 2; ++b)
#pragma unroll
                for (int m = 0; m < 4; ++m)
#pragma unroll
                    for (int n = 0; n < 2; ++n) acc[a][b][m][n] = (f32x4){0.f, 0.f, 0.f, 0.f};
    }
    __device__ __forceinline__ int mixsel(const Unit& u) const { return (round == 0) ? ((u.pn == 24) ? 2 : (u.pn >> 3)) : ((u.pn < 8) ? 0 : (u.pn == 8) ? 1 : 2); }
    __device__ __forceinline__ bool is_lora(const Unit& u) const { return (round == 0) ? (u.pn == 24) : (u.pn >= 8); }
    __device__ __forceinline__ const char* a_ptr(const Unit& u) const {
        const int j = mixsel(u);
        return (const char*)(A0 + ((j == 1) ? dA1 : (j == 2) ? dA2 : 0L) + (size_t)u.pm * BM * lda); }
    __device__ __forceinline__ const char* b_ptr(const Unit& u) const {
        size_t rowoff;
        if (round == 0) rowoff = (u.pn == 24) ? (size_t)(10240 + 512) : (size_t)u.pn * BM;
        else rowoff = (u.pn < 8) ? (size_t)(6144 + u.pn * BM) : (size_t)(10240 + (u.pn - 8) * BM);
        return (const char*)(Wt + rowoff * 2048); }
    __device__ __forceinline__ void epi(const f32x4 (&acc)[2][2][4][2], const Unit& u, int wr, int wc, int fr, int fq) const {
        EPI_ROWS(u);
        if (is_lora(u)) {
            const int lim = (round == 0) ? 64 : 96, cb = (round == 0) ? 192 : (u.pn - 8) * 96; const bool th = (round == 1 && u.pn == 8);
            const int c = wc * 32 + 8 * fq;
            if (c < lim) {
                if (th) {
                    EPI_FOR_RM { bf16_t* rowp = lora + (size_t)(row0 + ai * HALF + m * 16) * 256 + cb + c; f32x4 a = acc[ai][0][m][0], b = acc[ai][0][m][1];
#pragma unroll
                        for (int j = 0; j < 4; ++j) { a[j] = 1.f - 2.f / (__expf(2.f * a[j]) + 1.f); b[j] = 1.f - 2.f / (__expf(2.f * b[j]) + 1.f); }
                        *(u32x4*)rowp = PK8(a, b); }
                } else {
                    EPI_FOR_RM { bf16_t* rowp = lora + (size_t)(row0 + ai * HALF + m * 16) * 256 + cb + c; const f32x4 a = acc[ai][0][m][0], b = acc[ai][0][m][1];
                        *(u32x4*)rowp = PK8(a, b); }
                }
            }
            return;
        }
        const int j = (round == 0) ? (u.pn >> 3) : 3;
        bf16_t* O = O0 + ((j == 1) ? dO1 : (j == 2) ? dO2 : (j == 3) ? dO3 : 0L); const int col0 = (u.pn & 7) * BM + wc * 32 + 8 * fq;
        EPI_FOR_RM { bf16_t* rowp = O + (size_t)(row0 + ai * HALF + m * 16) * Dm + col0;
#pragma unroll
            for (int bj = 0; bj < 2; ++bj) *(u32x4*)(rowp + bj * HALF) = PK8(acc[ai][bj][m][0], acc[ai][bj][m][1]); }
    }
};
struct ProbRwkvUp {
    static constexpr bool PERM = true;
    int nM, nN, nt, lda, ldb;
    const bf16_t* A; const bf16_t* Bt;
    const float* w0; long d_a0, d_v0;
    bf16_t* E; bf16_t* AL; bf16_t* V; const bf16_t* VF;
    __device__ __forceinline__ void init_acc(f32x4 (&acc)[2][2][4][2], const Unit& u, int wr, int wc, int fr, int fq) const {
        const int kind = u.pn >> 3; const int col0 = (u.pn & 7) * BM + wc * 32 + 8 * fq;
        const float* bias = w0 + (kind == 1 ? d_a0 : kind == 2 ? d_v0 : 0L);
#pragma unroll
        for (int b = 0; b < 2; ++b)
#pragma unroll
            for (int n = 0; n < 2; ++n) { const f32x4 bvv = *(const f32x4*)(bias + col0 + b * HALF + 4 * n);
#pragma unroll
                for (int a = 0; a < 2; ++a)
#pragma unroll
                    for (int m = 0; m < 4; ++m) acc[a][b][m][n] = bvv; }
    }
    __device__ __forceinline__ const char* a_ptr(const Unit& u) const { return (const char*)(A + (size_t)u.pm * BM * lda); }
    __device__ __forceinline__ const char* b_ptr(const Unit& u) const { return (const char*)(Bt + (size_t)u.pn * BM * ldb); }
    __device__ __forceinline__ void epi(const f32x4 (&acc)[2][2][4][2], const Unit& u, int wr, int wc, int fr, int fq) const {
        EPI_ROWS(u); const int kind = u.pn >> 3; const int col0 = (u.pn & 7) * BM + wc * 32 + 8 * fq;
        if (kind == 0) {
            EPI_FOR_RM { const size_t ro = (size_t)(row0 + ai * HALF + m * 16) * Dm + col0;
#pragma unroll
                for (int bj = 0; bj < 2; ++bj) { f32x4 a = acc[ai][bj][m][0], b = acc[ai][bj][m][1];
#pragma unroll
                    for (int j = 0; j < 4; ++j) { a[j] = 0.6065306597126334f * sigmoidf_(a[j]); b[j] = 0.6065306597126334f * sigmoidf_(b[j]); }
                    u32x4 o; o.x = pkh2(a[0], a[1]); o.y = pkh2(a[2], a[3]); o.z = pkh2(b[0], b[1]); o.w = pkh2(b[2], b[3]);
                    *(u32x4*)(E + ro + bj * HALF) = o; } }
        } else if (kind == 1) {
            EPI_FOR_RM { const size_t ro = (size_t)(row0 + ai * HALF + m * 16) * Dm + col0;
#pragma unroll
                for (int bj = 0; bj < 2; ++bj) { f32x4 a = acc[ai][bj][m][0], b = acc[ai][bj][m][1];
#pragma unroll
                    for (int j = 0; j < 4; ++j) { a[j] = sigmoidf_(a[j]); b[j] = sigmoidf_(b[j]); }
                    u32x4 o; o.x = pkh2(a[0], a[1]); o.y = pkh2(a[2], a[3]); o.z = pkh2(b[0], b[1]); o.w = pkh2(b[2], b[3]);
                    *(u32x4*)(AL + ro + bj * HALF) = o; } }
        } else {
            EPI_FOR_RM { const size_t ro = (size_t)(row0 + ai * HALF + m * 16) * Dm + col0;
#pragma unroll
                for (int bj = 0; bj < 2; ++bj) { f32x4 a = acc[ai][bj][m][0], b = acc[ai][bj][m][1];
                    const u32x4 vv = *(const u32x4*)(V + ro + bj * HALF), vf = *(const u32x4*)(VF + ro + bj * HALF);
                    u32x4 o;
                    { const float p0 = bf_lo(vv.x), p1 = bf_hi(vv.x); o.x = pk2(p0 + (bf_lo(vf.x) - p0) * sigmoidf_(a[0]), p1 + (bf_hi(vf.x) - p1) * sigmoidf_(a[1])); }
                    { const float p0 = bf_lo(vv.y), p1 = bf_hi(vv.y); o.y = pk2(p0 + (bf_lo(vf.y) - p0) * sigmoidf_(a[2]), p1 + (bf_hi(vf.y) - p1) * sigmoidf_(a[3])); }
                    { const float p0 = bf_lo(vv.z), p1 = bf_hi(vv.z); o.z = pk2(p0 + (bf_lo(vf.z) - p0) * sigmoidf_(b[0]), p1 + (bf_hi(vf.z) - p1) * sigmoidf_(b[1])); }
                    { const float p0 = bf_lo(vv.w), p1 = bf_hi(vv.w); o.w = pk2(p0 + (bf_lo(vf.w) - p0) * sigmoidf_(b[2]), p1 + (bf_hi(vf.w) - p1) * sigmoidf_(b[3])); }
                    *(u32x4*)(V + ro + bj * HALF) = o; } }
        }
    }
};
struct ProbPoolGrp {
    static constexpr bool PERM = true;
    int nM, nN, nt, lda, ldb;
    const bf16_t* A; const bf16_t* Bt; const float* scale; const bf16_t* UG; bf16_t* Z;
    __device__ __forceinline__ void init_acc(f32x4 (&acc)[2][2][4][2], const Unit&, int, int, int, int) const {
#pragma unroll
        for (int a = 0; a < 2; ++a)
#pragma unroll
            for (int b = 0; b < 2; ++b)
#pragma unroll
                for (int m = 0; m < 4; ++m)
#pragma unroll
                    for (int n = 0; n < 2; ++n) acc[a][b][m][n] = (f32x4){0.f, 0.f, 0.f, 0.f};
    }
    __device__ __forceinline__ const char* a_ptr(const Unit& u) const { return (const char*)(A + (size_t)u.pm * BM * lda + (u.pn >> 1) * 512); }
    __device__ __forceinline__ const char* b_ptr(const Unit& u) const { return (const char*)(Bt + (size_t)u.pn * BM * ldb); }
    __device__ __forceinline__ void epi(const f32x4 (&acc)[2][2][4][2], const Unit& u, int wr, int wc, int fr, int fq) const {
        EPI_ROWS(u); const int col0 = u.pn * BM + wc * 32 + 8 * fq;
        f32x4 sv[2][2];
#pragma unroll
        for (int bj = 0; bj < 2; ++bj) { sv[bj][0] = *(const f32x4*)(scale + col0 + bj * HALF); sv[bj][1] = *(const f32x4*)(scale + col0 + bj * HALF + 4); }
        EPI_FOR_RM { const size_t r = (size_t)(row0 + ai * HALF + m * 16);
#pragma unroll
            for (int bj = 0; bj < 2; ++bj) { const f32x4 v0 = acc[ai][bj][m][0] * sv[bj][0], v1 = acc[ai][bj][m][1] * sv[bj][1];
                const u32x4 gg = *(const u32x4*)(UG + r * 4096 + 2048 + col0 + bj * HALF);
                u32x4 o; o.x = pk2(v0[0] * siluf_(bf_lo(gg.x)), v0[1] * siluf_(bf_hi(gg.x))); o.y = pk2(v0[2] * siluf_(bf_lo(gg.y)), v0[3] * siluf_(bf_hi(gg.y)));
                o.z = pk2(v1[0] * siluf_(bf_lo(gg.z)), v1[1] * siluf_(bf_hi(gg.z))); o.w = pk2(v1[2] * siluf_(bf_lo(gg.w)), v1[3] * siluf_(bf_hi(gg.w)));
                *(u32x4*)(Z + r * Dm + col0 + bj * HALF) = o; } }
    }
};

__device__ __forceinline__ void transpose_item(const float* W, int sld, int N, bf16_t* WT, int dld, LAS float* scr, int item, int lane) {
    const int nblk = N / 32, kb = item / nblk, nb = item % nblk, k0 = 64 * kb, n0 = 32 * nb;
#pragma unroll 8
    for (int i = 0; i < 32; ++i) { const int kk = 2 * i + (lane >> 5); scr[kk * 33 + (lane & 31)] = W[(size_t)(k0 + kk) * sld + n0 + (lane & 31)]; }
    __builtin_amdgcn_fence(__ATOMIC_RELEASE, "wavefront"); __builtin_amdgcn_wave_barrier();
    const int c = lane & 7;
#pragma unroll
    for (int j = 0; j < 4; ++j) { const int n = (lane >> 3) + 8 * j; const LAS float* s = scr + (8 * c) * 33 + n;
        u32x4 o; o.x = pk2(s[0 * 33], s[1 * 33]); o.y = pk2(s[2 * 33], s[3 * 33]); o.z = pk2(s[4 * 33], s[5 * 33]); o.w = pk2(s[6 * 33], s[7 * 33]);
        *(u32x4*)(WT + (size_t)(n0 + n) * dld + k0 + 8 * c) = o; }
    __builtin_amdgcn_fence(__ATOMIC_RELEASE, "wavefront"); __builtin_amdgcn_wave_barrier();
}
struct TrJob { const float* W; int K, N, sld; bf16_t* WT; int dld; };
template <int NJ>
__device__ __forceinline__ void run_transposes(int tid, const TrJob (&jobs)[NJ], LAS unsigned char* lds) {
    const int wave = tid >> 6, lane = tid & 63, gw = blockIdx.x * NWAVE + wave, NGW = gridDim.x * NWAVE;
    LAS float* scr = (LAS float*)(lds + wave * 8448);
    int total = 0;
#pragma unroll
    for (int j = 0; j < NJ; ++j) total += (jobs[j].K / 64) * (jobs[j].N / 32);
    for (int it = gw; it < total; it += NGW) {
        int r = it;
#pragma unroll
        for (int j = 0; j < NJ; ++j) { const int cnt = (jobs[j].K / 64) * (jobs[j].N / 32);
            if (r >= 0 && r < cnt) transpose_item(jobs[j].W, jobs[j].sld, jobs[j].N, jobs[j].WT, jobs[j].dld, scr, r, lane);
            r -= cnt; }
    }
}

__device__ __forceinline__ void rwkv_weights(int tid, const Params& p, int ia, bool has_v, LAS unsigned char* lds) {
    bf16_t* Wt = (bf16_t*)(p.ws + WS_W);
    const float* win = p.in[4] + (size_t)ia * 4 * Dm * Dm;
    TrJob jobs[5];
#pragma unroll
    for (int j = 0; j < 4; ++j) jobs[j] = TrJob{win + (size_t)j * Dm * Dm, Dm, Dm, Dm, Wt + (size_t)j * Dm * Dm, Dm};
    jobs[4] = TrJob{p.in[19] + (size_t)ia * Dm * Dm, Dm, Dm, Dm, Wt + (size_t)8192 * 2048, Dm};
    run_transposes<5>(tid, jobs, lds);
    const float* w1 = p.in[6] + (size_t)ia * Dm * 96; const float* w2 = p.in[7] + (size_t)ia * 96 * Dm;
    const float* a1 = p.in[9] + (size_t)ia * Dm * 96; const float* a2 = p.in[10] + (size_t)ia * 96 * Dm;
    const float* v1 = p.in[17]; const float* v2 = p.in[18];
    bf16_t* Wd = Wt + (size_t)10240 * 2048; bf16_t* Wu = Wt + (size_t)11008 * 2048;
    const long gt = (long)blockIdx.x * NTHR + tid, GT = (long)gridDim.x * NTHR;
    const int ndt = has_v ? 3 : 2;
    for (long i = gt; i < (long)ndt * 256 * 256; i += GT) {
        const int n = (int)(i & 255), k8 = (int)((i >> 8) & 255), tile = (int)(i >> 16);
        const float* src = tile == 0 ? w1 : tile == 1 ? a1 : v1; const int rank = tile == 2 ? 64 : 96;
        float v[8];
#pragma unroll
        for (int j = 0; j < 8; ++j) v[j] = (n < rank) ? src[(size_t)(k8 * 8 + j) * rank + n] : 0.f;
        u32x4 o; o.x = pk2(v[0], v[1]); o.y = pk2(v[2], v[3]); o.z = pk2(v[4], v[5]); o.w = pk2(v[6], v[7]);
        *(u32x4*)(Wd + ((size_t)tile * 256 + n) * 2048 + k8 * 8) = o;
    }
    const int nup = has_v ? 6144 : 4096;
    for (long i = gt; i < (long)nup * 32; i += GT) {
        const int n = (int)(i % nup), k8 = (int)(i / nup), kind = n >> 11, nn = n & 2047;
        const float* src = kind == 0 ? w2 : kind == 1 ? a2 : v2; const int klo = kind * 96, rank = kind == 2 ? 64 : 96;
        float v[8];
#pragma unroll
        for (int j = 0; j < 8; ++j) { const int k = k8 * 8 + j - klo; v[j] = (k >= 0 && k < rank) ? src[(size_t)k * Dm + nn] : 0.f; }
        u32x4 o; o.x = pk2(v[0], v[1]); o.y = pk2(v[2], v[3]); o.z = pk2(v[4], v[5]); o.w = pk2(v[6], v[7]);
        *(u32x4*)(Wu + (size_t)n * 256 + k8 * 8) = o;
    }
}
template <bool XBF> __device__ __forceinline__ void ldrow8(const void* x, size_t t, int ck, f32x4& a, f32x4& b) {
    if (XBF) { const u32x4 r = __builtin_nontemporal_load((const u32x4*)((const bf16_t*)x + t * Dm) + ck);
        a = (f32x4){bf_lo(r.x), bf_hi(r.x), bf_lo(r.y), bf_hi(r.y)}; b = (f32x4){bf_lo(r.z), bf_hi(r.z), bf_lo(r.w), bf_hi(r.w)}; }
    else { const f32x4* p_ = (const f32x4*)((const float*)x + t * Dm) + 2 * ck; a = __builtin_nontemporal_load(p_); b = __builtin_nontemporal_load(p_ + 1); }
}
__device__ __forceinline__ float sq8(const f32x4& a, const f32x4& b) { return ((a.x * a.x + a.y * a.y) + (a.z * a.z + a.w * a.w)) + ((b.x * b.x + b.y * b.y) + (b.z * b.z + b.w * b.w)); }
template <int NMIX, bool XBF>
__device__ __forceinline__ void norm_mix_phase(int tid, const void* x, const float* nw, const float* mu0, const float* mu1, bf16_t* O0, bf16_t* O1, const float* mu2 = nullptr, bf16_t* O2 = nullptr) {
    const int wave = tid >> 6, lane = tid & 63, gw = blockIdx.x * NWAVE + wave, NGW = gridDim.x * NWAVE;
    for (int ch = gw; ch < T / 16; ch += NGW) {
        const int t0 = ch * 16;
        f32x4 hp[4][2];
        if (NMIX) {
            if ((t0 % SEQ) != 0) {
                float s = 0.f;
#pragma unroll
                for (int j = 0; j < 4; ++j) { ldrow8<XBF>(x, (size_t)(t0 - 1), lane + 64 * j, hp[j][0], hp[j][1]); s += sq8(hp[j][0], hp[j][1]); }
                const float rstd = rsqrtf(wave_sum(s) * (1.f / Dm) + RMS_EPS);
#pragma unroll
                for (int j = 0; j < 4; ++j) { hp[j][0] = hp[j][0] * rstd * ((const f32x4*)nw)[2 * (lane + 64 * j)]; hp[j][1] = hp[j][1] * rstd * ((const f32x4*)nw)[2 * (lane + 64 * j) + 1]; }
            } else {
#pragma unroll
                for (int j = 0; j < 4; ++j) { hp[j][0] = (f32x4){0.f, 0.f, 0.f, 0.f}; hp[j][1] = hp[j][0]; }
            }
        }
        f32x4 xn[4][2];
#pragma unroll
        for (int j = 0; j < 4; ++j) ldrow8<XBF>(x, (size_t)t0, lane + 64 * j, xn[j][0], xn[j][1]);
        for (int r = 0; r < 16; ++r) {
            const int t = t0 + r;
            f32x4 h[4][2]; float s = 0.f;
#pragma unroll
            for (int j = 0; j < 4; ++j) { h[j][0] = xn[j][0]; h[j][1] = xn[j][1]; s += sq8(h[j][0], h[j][1]); }
            if (r + 1 < 16) {
#pragma unroll
                for (int j = 0; j < 4; ++j) ldrow8<XBF>(x, (size_t)(t + 1), lane + 64 * j, xn[j][0], xn[j][1]); }
            const float rstd = rsqrtf(wave_sum(s) * (1.f / Dm) + RMS_EPS);
#pragma unroll
            for (int j = 0; j < 4; ++j) { h[j][0] = h[j][0] * rstd * ((const f32x4*)nw)[2 * (lane + 64 * j)]; h[j][1] = h[j][1] * rstd * ((const f32x4*)nw)[2 * (lane + 64 * j) + 1]; }
            if (NMIX) {
#pragma unroll
                for (int j = 0; j < 4; ++j) {
                    const int ck = lane + 64 * j;
                    const f32x4 d0 = hp[j][0] - h[j][0], d1 = hp[j][1] - h[j][1];
                    const f32x4 a0 = h[j][0] + d0 * ((const f32x4*)mu0)[2 * ck], a1 = h[j][1] + d1 * ((const f32x4*)mu0)[2 * ck + 1];
                    const f32x4 b0 = h[j][0] + d0 * ((const f32x4*)mu1)[2 * ck], b1 = h[j][1] + d1 * ((const f32x4*)mu1)[2 * ck + 1];
                    *((u32x4*)(O0 + (size_t)t * Dm) + ck) = PK8(a0, a1); *((u32x4*)(O1 + (size_t)t * Dm) + ck) = PK8(b0, b1);
                    if (NMIX == 3) { const f32x4 c0 = h[j][0] + d0 * ((const f32x4*)mu2)[2 * ck], c1 = h[j][1] + d1 * ((const f32x4*)mu2)[2 * ck + 1]; *((u32x4*)(O2 + (size_t)t * Dm) + ck) = PK8(c0, c1); }
                    hp[j][0] = h[j][0]; hp[j][1] = h[j][1];
                }
            } else {
#pragma unroll
                for (int j = 0; j < 4; ++j) *((u32x4*)(O0 + (size_t)t * Dm) + lane + 64 * j) = PK8(h[j][0], h[j][1]);
            }
        }
    }
}

constexpr int TC = 16, NCH = SEQ / TC;
constexpr int SC_OPS = 0, SC_VP = 2 * 5 * TC * 64 * 4, SC_BON = SC_VP + 3 * TC * 64 * 4, SC_YB = SC_BON + 3 * TC * 4 + 64, SC_PAIR = SC_YB + 2 * TC * 64 * 4;
static_assert(2 * SC_PAIR <= LDS_BYTES, "scan LDS");
struct ScanOps { f32x4 w[4], a[4], b[4], k[4], r[4]; f32x2 v; };
#define SC_PAIROF(arr, cp) (((cp) & 1) ? __builtin_shufflevector(arr[(cp) >> 1], arr[(cp) >> 1], 2, 3) : __builtin_shufflevector(arr[(cp) >> 1], arr[(cp) >> 1], 0, 1))
#define SC_LOAD(O, s_) do { _Pragma("unroll") for (int q = 0; q < 4; ++q) { O.w[q] = *(const LAS f32x4*)(ob + 0 * TC * 64 + (s_) * 64 + 4 * q); O.a[q] = *(const LAS f32x4*)(ob + 1 * TC * 64 + (s_) * 64 + 4 * q); \
        O.b[q] = *(const LAS f32x4*)(ob + 2 * TC * 64 + (s_) * 64 + 4 * q); O.k[q] = *(const LAS f32x4*)(ob + 3 * TC * 64 + (s_) * 64 + 4 * q); O.r[q] = *(const LAS f32x4*)(ob + 4 * TC * 64 + (s_) * 64 + 4 * q); } \
        O.v = *(const LAS f32x2*)(vb + (s_) * 64); } while (0)
#define SC_STEP(O, s_) do { float sa[2], y[2]; \
        _Pragma("unroll") for (int i = 0; i < 2; ++i) { f32x2 t = S2[i][0] * SC_PAIROF(O.a, 0); \
            _Pragma("unroll") for (int cp = 1; cp < 8; ++cp) t = S2[i][cp] * SC_PAIROF(O.a, cp) + t; \
            sa[i] = quad_sum(t.x + t.y); } \
        _Pragma("unroll") for (int i = 0; i < 2; ++i) { const f32x2 sav = (f32x2){sa[i], sa[i]}, vv = (f32x2){O.v[i], O.v[i]}; f32x2 t; \
            _Pragma("unroll") for (int cp = 0; cp < 8; ++cp) { f32x2 u = sav * SC_PAIROF(O.b, cp); u = vv * SC_PAIROF(O.k, cp) + u; S2[i][cp] = S2[i][cp] * SC_PAIROF(O.w, cp) + u; \
                t = (cp == 0) ? S2[i][0] * SC_PAIROF(O.r, 0) : S2[i][cp] * SC_PAIROF(O.r, cp) + t; } \
            y[i] = quad_sum(t.x + t.y); } \
        if (jg == 0) *(LAS f32x2*)(yb + (s_) * 64) = (f32x2){y[0], y[1]}; } while (0)
__device__ __forceinline__ void scan_phase(int tid, LAS unsigned char* lds, const bf16_t* R, const bf16_t* E, const bf16_t* Kb, const bf16_t* V, const bf16_t* AL, const bf16_t* G,
                                           const float* k_k, const float* k_a, const float* r_k, const float* lnw, const float* lnb, bf16_t* Z) {
    const int wave = __builtin_amdgcn_readfirstlane(tid >> 6), lane = tid & 63;
    const int role = (wave < 4) ? 0 : (wave < 6) ? 1 : 2, pi = (wave < 4) ? (wave >> 1) : (wave & 1), hf = wave & 1;
    LAS unsigned char* base = lds + pi * SC_PAIR;
    LAS float* OPS = (LAS float*)(base + SC_OPS); LAS float* VP = (LAS float*)(base + SC_VP); LAS float* BON = (LAS float*)(base + SC_BON); LAS float* YB = (LAS float*)(base + SC_YB);
    for (int pb = blockIdx.x * 2; pb < NB * 32; pb += gridDim.x * 2) {
        const int pair = pb + pi, b = pair >> 5, h = pair & 31;
        const size_t gbase = (size_t)b * SEQ * Dm + h * 64;
        const int st = lane >> 2, cgp = lane & 3;
        const int ig = lane >> 2, jg = lane & 3;
        if (role == 0) {
            f32x2 S2[2][8];
#pragma unroll
            for (int i = 0; i < 2; ++i)
#pragma unroll
                for (int c = 0; c < 8; ++c) S2[i][c] = (f32x2){0.f, 0.f};
            for (int it = 0; it < NCH + 2; ++it) {
                if (it >= 1 && it <= NCH) {
                    const int c_ = it - 1;
                    const LAS float* ob = OPS + (c_ & 1) * (5 * TC * 64) + 16 * jg;
                    const LAS float* vb = VP + (c_ % 3) * (TC * 64) + 32 * hf + 2 * ig;
                    LAS float* yb = YB + (c_ & 1) * (TC * 64) + 32 * hf + 2 * ig;
                    ScanOps OA, OB;
                    SC_LOAD(OA, 0);
#pragma unroll 1
                    for (int s = 0; s < TC; s += 2) {
                        SC_LOAD(OB, s + 1);
                        SC_STEP(OA, s);
                        if (s + 2 < TC) SC_LOAD(OA, s + 2);
                        SC_STEP(OB, s + 1);
                    }
                }
                __syncthreads();
            }
        } else if (role == 1) {
            float ckk[16], cka[16], crk[16];
            u32x4 raw[10];
#pragma unroll
            for (int c = 0; c < 16; ++c) { ckk[c] = k_k[h * 64 + 16 * cgp + c]; cka[c] = k_a[h * 64 + 16 * cgp + c]; crk[c] = r_k[h * 64 + 16 * cgp + c]; }
            const size_t go = gbase + (size_t)st * Dm + 16 * cgp;
            raw[0] = *(const u32x4*)(R + go); raw[1] = *(const u32x4*)(R + go + 8); raw[2] = *(const u32x4*)(Kb + go); raw[3] = *(const u32x4*)(Kb + go + 8);
            raw[4] = *(const u32x4*)(V + go); raw[5] = *(const u32x4*)(V + go + 8); raw[6] = *(const u32x4*)(E + go); raw[7] = *(const u32x4*)(E + go + 8);
            raw[8] = *(const u32x4*)(AL + go); raw[9] = *(const u32x4*)(AL + go + 8);
          for (int it = 0; it < NCH + 2; ++it) {
            if (it < NCH) {
                const unsigned rw[8] = {raw[0].x, raw[0].y, raw[0].z, raw[0].w, raw[1].x, raw[1].y, raw[1].z, raw[1].w}, kw[8] = {raw[2].x, raw[2].y, raw[2].z, raw[2].w, raw[3].x, raw[3].y, raw[3].z, raw[3].w};
                const unsigned vw[8] = {raw[4].x, raw[4].y, raw[4].z, raw[4].w, raw[5].x, raw[5].y, raw[5].z, raw[5].w}, ew[8] = {raw[6].x, raw[6].y, raw[6].z, raw[6].w, raw[7].x, raw[7].y, raw[7].z, raw[7].w};
                const unsigned aw[8] = {raw[8].x, raw[8].y, raw[8].z, raw[8].w, raw[9].x, raw[9].y, raw[9].z, raw[9].w};
                float rr[16], kk[16], vv[16], ww[16], lr[16], kn[16];
#pragma unroll
                for (int j = 0; j < 8; ++j) { rr[2 * j] = bf_lo(rw[j]); rr[2 * j + 1] = bf_hi(rw[j]); kk[2 * j] = bf_lo(kw[j]); kk[2 * j + 1] = bf_hi(kw[j]);
                    vv[2 * j] = bf_lo(vw[j]); vv[2 * j + 1] = bf_hi(vw[j]); ww[2 * j] = __expf(-h_lo(ew[j])); ww[2 * j + 1] = __expf(-h_hi(ew[j]));
                    lr[2 * j] = h_lo(aw[j]); lr[2 * j + 1] = h_hi(aw[j]); }
                if (it + 1 < NCH) {
                    const size_t go = gbase + (size_t)((it + 1) * TC + st) * Dm + 16 * cgp;
                    raw[0] = *(const u32x4*)(R + go); raw[1] = *(const u32x4*)(R + go + 8); raw[2] = *(const u32x4*)(Kb + go); raw[3] = *(const u32x4*)(Kb + go + 8);
                    raw[4] = *(const u32x4*)(V + go); raw[5] = *(const u32x4*)(V + go + 8); raw[6] = *(const u32x4*)(E + go); raw[7] = *(const u32x4*)(E + go + 8);
                    raw[8] = *(const u32x4*)(AL + go); raw[9] = *(const u32x4*)(AL + go + 8);
                }
                float ss = 0.f;
#pragma unroll
                for (int c = 0; c < 16; ++c) { kn[c] = kk[c] * ckk[c]; ss += kn[c] * kn[c]; }
                ss = quad_sum(ss);
                const float inv = 1.f / fmaxf(sqrtf(ss), 1e-12f);
                float bon = 0.f; float av[16], bv[16], kp[16];
#pragma unroll
                for (int c = 0; c < 16; ++c) { kn[c] *= inv; av[c] = -kn[c]; bv[c] = kn[c] * lr[c]; kp[c] = kk[c] * (1.f + (lr[c] - 1.f) * cka[c]); bon += rr[c] * kp[c] * crk[c]; }
                bon = quad_sum(bon);
                LAS float* ob = OPS + (it & 1) * (5 * TC * 64) + st * 64 + 16 * cgp;
#pragma unroll
                for (int q = 0; q < 4; ++q) {
                    *(LAS f32x4*)(ob + 0 * TC * 64 + 4 * q) = (f32x4){ww[4 * q], ww[4 * q + 1], ww[4 * q + 2], ww[4 * q + 3]};
                    *(LAS f32x4*)(ob + 1 * TC * 64 + 4 * q) = (f32x4){av[4 * q], av[4 * q + 1], av[4 * q + 2], av[4 * q + 3]};
                    *(LAS f32x4*)(ob + 2 * TC * 64 + 4 * q) = (f32x4){bv[4 * q], bv[4 * q + 1], bv[4 * q + 2], bv[4 * q + 3]};
                    *(LAS f32x4*)(ob + 3 * TC * 64 + 4 * q) = (f32x4){kp[4 * q], kp[4 * q + 1], kp[4 * q + 2], kp[4 * q + 3]};
                    *(LAS f32x4*)(ob + 4 * TC * 64 + 4 * q) = (f32x4){rr[4 * q], rr[4 * q + 1], rr[4 * q + 2], rr[4 * q + 3]};
                    *(LAS f32x4*)(VP + (it % 3) * (TC * 64) + st * 64 + 16 * cgp + 4 * q) = (f32x4){vv[4 * q], vv[4 * q + 1], vv[4 * q + 2], vv[4 * q + 3]};
                }
                if (cgp == 0) BON[(it % 3) * TC + st] = bon;
            }
            __syncthreads();
          }
        } else {
            float ckk[16], cka[16];
#pragma unroll
            for (int c = 0; c < 16; ++c) { ckk[c] = lnw[h * 64 + 16 * cgp + c]; cka[c] = lnb[h * 64 + 16 * cgp + c]; }
          for (int it = 0; it < NCH + 2; ++it) {
            if (it >= 2) {
                const int c_ = it - 2;
                const size_t go = gbase + (size_t)(c_ * TC + st) * Dm + 16 * cgp;
                const u32x4 g0 = *(const u32x4*)(G + go), g1 = *(const u32x4*)(G + go + 8);
                const LAS float* yb = YB + (c_ & 1) * (TC * 64) + st * 64 + 16 * cgp;
                const LAS float* vb = VP + (c_ % 3) * (TC * 64) + st * 64 + 16 * cgp;
                float y[16], vv[16];
#pragma unroll
                for (int q = 0; q < 4; ++q) { const f32x4 t = *(const LAS f32x4*)(yb + 4 * q), u = *(const LAS f32x4*)(vb + 4 * q);
                    y[4 * q] = t.x; y[4 * q + 1] = t.y; y[4 * q + 2] = t.z; y[4 * q + 3] = t.w; vv[4 * q] = u.x; vv[4 * q + 1] = u.y; vv[4 * q + 2] = u.z; vv[4 * q + 3] = u.w; }
                const float bon = BON[(c_ % 3) * TC + st];
                float s = 0.f;
#pragma unroll
                for (int c = 0; c < 16; ++c) s += y[c];
                const float mean = quad_sum(s) * (1.f / 64.f);
                float s2 = 0.f;
#pragma unroll
                for (int c = 0; c < 16; ++c) { y[c] -= mean; s2 += y[c] * y[c]; }
                const float rstd = rsqrtf(quad_sum(s2) * (1.f / 64.f) + LN_EPS);
                const unsigned gw_[8] = {g0.x, g0.y, g0.z, g0.w, g1.x, g1.y, g1.z, g1.w}; unsigned ow[8];
#pragma unroll
                for (int j = 0; j < 8; ++j) {
                    const float z0 = (y[2 * j] * rstd * ckk[2 * j] + cka[2 * j] + bon * vv[2 * j]) * siluf_(bf_lo(gw_[j]));
                    const float z1 = (y[2 * j + 1] * rstd * ckk[2 * j + 1] + cka[2 * j + 1] + bon * vv[2 * j + 1]) * siluf_(bf_hi(gw_[j]));
                    ow[j] = pk2(z0, z1); }
                *(u32x4*)(Z + go) = (u32x4){ow[0], ow[1], ow[2], ow[3]}; *(u32x4*)(Z + go + 8) = (u32x4){ow[4], ow[5], ow[6], ow[7]};
            }
            __syncthreads();
          }
        }
    }
}
__device__ __forceinline__ void attn_weights(int tid, const Params& p, LAS unsigned char* lds) {
    bf16_t* Wt = (bf16_t*)(p.ws + WS_W);
    TrJob jobs[2];
    jobs[0] = TrJob{p.in[20], Dm, 10240, 10240, Wt, Dm};
    jobs[1] = TrJob{p.in[23], 1024, Dm, Dm, Wt + (size_t)10240 * 2048, 1024};
    run_transposes<2>(tid, jobs, lds);
    float* COS = (float*)(p.ws + WS_COS); float* SIN = (float*)(p.ws + WS_SIN);
    const long gt = (long)blockIdx.x * NTHR + tid, GT = (long)gridDim.x * NTHR;
    for (long i = gt; i < (long)T * 16; i += GT) {
        const int t = (int)(i >> 4), f = (int)(i & 15);
        const float inv = powf(500000.0f, -(float)(2 * f) / 32.0f);
        const float ang = (float)p.positions[t] * inv; float s, c; sincosf(ang, &s, &c);
        COS[i] = c; SIN[i] = s;
    }
}
__device__ __forceinline__ void pool_weights(int tid, const Params& p, LAS unsigned char* lds) {
    bf16_t* Wt = (bf16_t*)(p.ws + WS_W);
    TrJob jobs[6];
    jobs[0] = TrJob{p.in[24], Dm, 4096, 4096, Wt, Dm};
#pragma unroll
    for (int g = 0; g < 4; ++g) jobs[1 + g] = TrJob{p.in[25] + (size_t)g * 512 * 512, 512, 512, 512, Wt + (size_t)4096 * 2048 + (size_t)g * 512 * 512, 512};
    jobs[5] = TrJob{p.in[27], Dm, Dm, Dm, Wt + (size_t)4096 * 2048 + (size_t)2048 * 512, Dm};
    run_transposes<6>(tid, jobs, lds);
}

__device__ __forceinline__ unsigned off_b(unsigned row, unsigned ch) { return 256u * row + 16u * (ch ^ (((row & 3) << 2) | ((row >> 2) & 3))); }
__device__ __forceinline__ void attn_phase(int tid, LAS unsigned char* lds, bf16_t* QKVG, float* LSE, const float* qn_w, const float* kn_w, const float* COS, const float* SIN) {
    const int w = __builtin_amdgcn_readfirstlane(tid >> 6), lane = tid & 63, fr = lane & 15, g4 = lane >> 4;
    LAS unsigned char* Kt = lds; LAS unsigned char* Vt = lds + 65536;
    const float scale = 0.08838834764831845f;
    for (int item = blockIdx.x; item < NB * 8 * 48; item += gridDim.x) {
        const int bh = item / 48, r = item % 48, b = bh >> 3, hh = bh & 7;
        int g, dil, rho, n;
        if (r < 16) { g = 0; dil = 1; rho = 0; n = r; } else if (r < 32) { g = 1; dil = 4; rho = (r - 16) >> 2; n = (r - 16) & 3; } else { g = 2; dil = 16; rho = r - 32; n = 0; }
        const int qcol = (g * 8 + hh) * 128, kcol = 3072 + qcol, vcol = 6144 + qcol;
        const size_t tok0 = (size_t)b * SEQ + rho;
        __syncthreads();
        {
            const int ch = tid & 15; const float sgk = (ch < 2) ? -1.f : 1.f;
            const f32x4 kw0 = *(const f32x4*)(kn_w + g * 128 + ch * 8), kw1 = *(const f32x4*)(kn_w + g * 128 + ch * 8 + 4);
            const float kwv[8] = {kw0.x, kw0.y, kw0.z, kw0.w, kw1.x, kw1.y, kw1.z, kw1.w};
#pragma unroll
            for (int ih = 0; ih < 2; ++ih) {
                u32x4 kv[4], vv[4]; f32x4 cs[4][4];
#pragma unroll
                for (int i2 = 0; i2 < 4; ++i2) {
                    const int row = (tid >> 4) + 32 * (4 * ih + i2), s = 128 * (n - 1) + row;
                    kv[i2] = (u32x4){0u, 0u, 0u, 0u}; vv[i2] = kv[i2];
#pragma unroll
                    for (int q = 0; q < 4; ++q) cs[i2][q] = (f32x4){0.f, 0.f, 0.f, 0.f};
                    if (s >= 0) { const size_t tk = tok0 + (size_t)dil * s; const bf16_t* src = QKVG + tk * 10240 + ch * 8; kv[i2] = *(const u32x4*)(src + kcol); vv[i2] = *(const u32x4*)(src + vcol);
                        if (ch < 4) { const float* cp = COS + tk * 16 + (ch & 1) * 8; const float* sp = SIN + tk * 16 + (ch & 1) * 8;
                            cs[i2][0] = *(const f32x4*)cp; cs[i2][1] = *(const f32x4*)(cp + 4); cs[i2][2] = *(const f32x4*)sp; cs[i2][3] = *(const f32x4*)(sp + 4); } }
                }
#pragma unroll
                for (int i2 = 0; i2 < 4; ++i2) {
                    const int row = (tid >> 4) + 32 * (4 * ih + i2);
                    const unsigned rw[4] = {kv[i2].x, kv[i2].y, kv[i2].z, kv[i2].w};
                    float x[8]; float ss = 0.f;
#pragma unroll
                    for (int j = 0; j < 4; ++j) { x[2 * j] = bf_lo(rw[j]); x[2 * j + 1] = bf_hi(rw[j]); ss += x[2 * j] * x[2 * j] + x[2 * j + 1] * x[2 * j + 1]; }
                    const float rstd = rsqrtf(row16_sum(ss) * (1.f / 128.f) + RMS_EPS);
                    const float cv[8] = {cs[i2][0].x, cs[i2][0].y, cs[i2][0].z, cs[i2][0].w, cs[i2][1].x, cs[i2][1].y, cs[i2][1].z, cs[i2][1].w};
                    const float sv[8] = {cs[i2][2].x, cs[i2][2].y, cs[i2][2].z, cs[i2][2].w, cs[i2][3].x, cs[i2][3].y, cs[i2][3].z, cs[i2][3].w};
#pragma unroll
                    for (int j = 0; j < 8; ++j) { x[j] = x[j] * rstd * kwv[j];
                        const float px = __int_as_float(__builtin_amdgcn_update_dpp(0, __float_as_int(x[j]), 0x4E, 0xF, 0xF, true));
                        x[j] = (ch < 4) ? x[j] * cv[j] + sgk * px * sv[j] : x[j]; }
                    u32x4 ko; ko.x = pk2(x[0], x[1]); ko.y = pk2(x[2], x[3]); ko.z = pk2(x[4], x[5]); ko.w = pk2(x[6], x[7]);
                    *(LAS u32x4*)(Kt + off_b(row, ch)) = ko; *(LAS u32x4*)(Vt + off_b(row, ch)) = vv[i2];
                }
            }
        }
        const size_t qtok = tok0 + (size_t)dil * (128 * n + 16 * w + fr);
        bf16x8 qf[4];
        {
            u32x4 qr[4]; f32x4 qw[4][2];
#pragma unroll
            for (int ks = 0; ks < 4; ++ks) { qr[ks] = *(const u32x4*)(QKVG + qtok * 10240 + qcol + 32 * ks + 8 * g4);
                qw[ks][0] = *(const f32x4*)(qn_w + g * 128 + 32 * ks + 8 * g4); qw[ks][1] = *(const f32x4*)(qn_w + g * 128 + 32 * ks + 8 * g4 + 4); }
            const float* cp = COS + qtok * 16 + (g4 & 1) * 8; const float* sp = SIN + qtok * 16 + (g4 & 1) * 8;
            const f32x4 c0 = *(const f32x4*)cp, c1 = *(const f32x4*)(cp + 4), s0 = *(const f32x4*)sp, s1 = *(const f32x4*)(sp + 4);
            float x[4][8]; float ss = 0.f;
#pragma unroll
            for (int ks = 0; ks < 4; ++ks) { const unsigned rw[4] = {qr[ks].x, qr[ks].y, qr[ks].z, qr[ks].w};
#pragma unroll
                for (int j = 0; j < 4; ++j) { x[ks][2 * j] = bf_lo(rw[j]); x[ks][2 * j + 1] = bf_hi(rw[j]); ss += x[ks][2 * j] * x[ks][2 * j] + x[ks][2 * j + 1] * x[ks][2 * j + 1]; } }
            ss += __shfl_xor(ss, 16); ss += __shfl_xor(ss, 32);
            const float rstd = rsqrtf(ss * (1.f / 128.f) + RMS_EPS);
#pragma unroll
            for (int ks = 0; ks < 4; ++ks)
#pragma unroll
                for (int j = 0; j < 8; ++j) x[ks][j] = x[ks][j] * rstd * qw[ks][j >> 2][j & 3];
            const float cv[8] = {c0.x, c0.y, c0.z, c0.w, c1.x, c1.y, c1.z, c1.w}, sv[8] = {s0.x, s0.y, s0.z, s0.w, s1.x, s1.y, s1.z, s1.w};
            const float sgq = (g4 < 2) ? -1.f : 1.f;
#pragma unroll
            for (int j = 0; j < 8; ++j) { const float px = __shfl_xor(x[0][j], 32); x[0][j] = x[0][j] * cv[j] + sgq * px * sv[j]; }
#pragma unroll
            for (int ks = 0; ks < 4; ++ks) { u32x4 t; t.x = pk2(x[ks][0], x[ks][1]); t.y = pk2(x[ks][2], x[ks][3]); t.z = pk2(x[ks][4], x[ks][5]); t.w = pk2(x[ks][6], x[ks][7]); qf[ks] = __builtin_bit_cast(bf16x8, t); }
        }
        __syncthreads();
        f32x4 sacc[9];
#pragma unroll
        for (int kbi = 0; kbi < 9; ++kbi) { sacc[kbi] = (f32x4){0.f, 0.f, 0.f, 0.f};
#pragma unroll
            for (int ks = 0; ks < 4; ++ks) { const bf16x8 kf = *(const LAS bf16x8*)(Kt + off_b(16 * (w + kbi) + fr, 4 * ks + g4));
                sacc[kbi] = __builtin_amdgcn_mfma_f32_16x16x32_bf16(kf, qf[ks], sacc[kbi], 0, 0, 0); } }
        const int qi = 16 * w + fr;
        float mx = -3.0e38f;
#pragma unroll
        for (int kbi = 0; kbi < 9; ++kbi)
#pragma unroll
            for (int j = 0; j < 4; ++j) { const int kj = 16 * (w + kbi) + 4 * g4 + j; const bool ok = (kj >= qi) && (kj <= qi + 128) && (n > 0 || kj >= 128);
                const float sv = ok ? sacc[kbi][j] * scale : -3.0e38f; sacc[kbi][j] = sv; mx = fmaxf(mx, sv); }
        mx = fmaxf(mx, __shfl_xor(mx, 16)); mx = fmaxf(mx, __shfl_xor(mx, 32));
        float l = 0.f;
#pragma unroll
        for (int kbi = 0; kbi < 9; ++kbi)
#pragma unroll
            for (int j = 0; j < 4; ++j) { const float pv = (sacc[kbi][j] > -1.0e38f) ? __expf(sacc[kbi][j] - mx) : 0.f; sacc[kbi][j] = pv; l += pv; }
        l += __shfl_xor(l, 16); l += __shfl_xor(l, 32);
        if (g4 == 0) LSE[((size_t)g * T + qtok) * 8 + hh] = mx + __logf(l);
        bf16x8 pb[5];
#pragma unroll
        for (int s5 = 0; s5 < 5; ++s5) { u32x4 t;
            t.x = pk2(sacc[2 * s5][0], sacc[2 * s5][1]); t.y = pk2(sacc[2 * s5][2], sacc[2 * s5][3]);
            if (s5 < 4) { t.z = pk2(sacc[2 * s5 + 1][0], sacc[2 * s5 + 1][1]); t.w = pk2(sacc[2 * s5 + 1][2], sacc[2 * s5 + 1][3]); } else { t.z = 0u; t.w = 0u; }
            pb[s5] = __builtin_bit_cast(bf16x8, t); }
        const float rl = 1.f / l;
        const unsigned q_ = fr >> 2, p_ = fr & 3;
        bf16_t* orow = QKVG + qtok * 10240 + qcol + 4 * g4;
#pragma unroll
        for (int c = 0; c < 8; ++c) {
            const unsigned vbase = (unsigned)(size_t)Vt + 256u * (16u * w + 4u * g4 + q_) + 16u * ((2u * c + (p_ >> 1)) ^ ((q_ << 2) | (unsigned)g4)) + 8u * (p_ & 1);
            u32x2 t0, t1, t2, t3, t4, t5, t6, t7, t8;
            asm volatile("ds_read_b64_tr_b16 %0, %9 offset:0\n\tds_read_b64_tr_b16 %1, %9 offset:4096\n\tds_read_b64_tr_b16 %2, %9 offset:8192\n\t"
                         "ds_read_b64_tr_b16 %3, %9 offset:12288\n\tds_read_b64_tr_b16 %4, %9 offset:16384\n\tds_read_b64_tr_b16 %5, %9 offset:20480\n\t"
                         "ds_read_b64_tr_b16 %6, %9 offset:24576\n\tds_read_b64_tr_b16 %7, %9 offset:28672\n\tds_read_b64_tr_b16 %8, %9 offset:32768\n\t"
                         "s_waitcnt lgkmcnt(0)"
                         : "=&v"(t0), "=&v"(t1), "=&v"(t2), "=&v"(t3), "=&v"(t4), "=&v"(t5), "=&v"(t6), "=&v"(t7), "=&v"(t8) : "v"(vbase) : "memory");
            f32x4 oacc = (f32x4){0.f, 0.f, 0.f, 0.f};
            oacc = __builtin_amdgcn_mfma_f32_16x16x32_bf16(__builtin_bit_cast(bf16x8, (u32x4){t0.x, t0.y, t1.x, t1.y}), pb[0], oacc, 0, 0, 0);
            oacc = __builtin_amdgcn_mfma_f32_16x16x32_bf16(__builtin_bit_cast(bf16x8, (u32x4){t2.x, t2.y, t3.x, t3.y}), pb[1], oacc, 0, 0, 0);
            oacc = __builtin_amdgcn_mfma_f32_16x16x32_bf16(__builtin_bit_cast(bf16x8, (u32x4){t4.x, t4.y, t5.x, t5.y}), pb[2], oacc, 0, 0, 0);
            oacc = __builtin_amdgcn_mfma_f32_16x16x32_bf16(__builtin_bit_cast(bf16x8, (u32x4){t6.x, t6.y, t7.x, t7.y}), pb[3], oacc, 0, 0, 0);
            oacc = __builtin_amdgcn_mfma_f32_16x16x32_bf16(__builtin_bit_cast(bf16x8, (u32x4){t8.x, t8.y, t8.x, t8.y}), pb[4], oacc, 0, 0, 0);
            u32x2 o; o.x = pk2(oacc[0] * rl, oacc[1] * rl); o.y = pk2(oacc[2] * rl, oacc[3] * rl);
            *(u32x2*)(orow + 16 * c) = o;
        }
    }
}
__device__ __forceinline__ void attn_combine_phase(int tid, const bf16_t* QKVG, const float* LSE, bf16_t* Z) {
    const long gt = (long)blockIdx.x * NTHR + tid, GT = (long)gridDim.x * NTHR;
    for (long i = gt; i < (long)T * 128; i += GT) {
        const size_t t = (size_t)(i >> 7); const int hh = (int)((i >> 4) & 7), d8 = (int)(i & 15);
        const float l0 = LSE[((size_t)0 * T + t) * 8 + hh], l1 = LSE[((size_t)1 * T + t) * 8 + hh], l2 = LSE[((size_t)2 * T + t) * 8 + hh];
        const float mx = fmaxf(l0, fmaxf(l1, l2)); float w0 = __expf(l0 - mx), w1 = __expf(l1 - mx), w2 = __expf(l2 - mx); const float rs = 1.f / (w0 + w1 + w2); w0 *= rs; w1 *= rs; w2 *= rs;
        const bf16_t* row = QKVG + t * 10240 + hh * 128 + d8 * 8;
        const u32x4 o0 = *(const u32x4*)row, o1 = *(const u32x4*)(row + 1024), o2 = *(const u32x4*)(row + 2048), gg = *(const u32x4*)(row + 9216);
        const unsigned a0[4] = {o0.x, o0.y, o0.z, o0.w}, a1[4] = {o1.x, o1.y, o1.z, o1.w}, a2[4] = {o2.x, o2.y, o2.z, o2.w}, ga[4] = {gg.x, gg.y, gg.z, gg.w}; unsigned ow[4];
#pragma unroll
        for (int j = 0; j < 4; ++j) {
            const float lo = (w0 * bf_lo(a0[j]) + w1 * bf_lo(a1[j]) + w2 * bf_lo(a2[j])) * siluf_(bf_lo(ga[j]));
            const float hi = (w0 * bf_hi(a0[j]) + w1 * bf_hi(a1[j]) + w2 * bf_hi(a2[j])) * siluf_(bf_hi(ga[j]));
            ow[j] = pk2(lo, hi); }
        *(u32x4*)(Z + t * 1024 + hh * 128 + d8 * 8) = (u32x4){ow[0], ow[1], ow[2], ow[3]};
    }
}
__device__ __forceinline__ void pool_diff_phase(int tid, const bf16_t* UG, bf16_t* DIFF) {
    const long gt = (long)blockIdx.x * NTHR + tid, GT = (long)gridDim.x * NTHR;
    for (long i = gt; i < (long)NB * 32 * 256; i += GT) {
        const int c8 = (int)(i & 255), chunk = (int)((i >> 8) & 31), b = (int)(i >> 13);
        const int win = 2 << (c8 >> 6); const float rwin = 1.f / (float)win;
        const int t0 = chunk * 64;
        const bf16_t* ub = UG + (size_t)b * SEQ * 4096 + c8 * 8;
        float sum[8];
#pragma unroll
        for (int j = 0; j < 8; ++j) sum[j] = 0.f;
        for (int s = t0 - win + 1; s < t0; ++s) if (s >= 0) { const u32x4 v = *(const u32x4*)(ub + (size_t)s * 4096); const unsigned vw[4] = {v.x, v.y, v.z, v.w};
#pragma unroll
            for (int j = 0; j < 4; ++j) { sum[2 * j] += bf_lo(vw[j]); sum[2 * j + 1] += bf_hi(vw[j]); } }
        for (int t = t0; t < t0 + 64; ++t) {
            const u32x4 v = *(const u32x4*)(ub + (size_t)t * 4096); const unsigned vw[4] = {v.x, v.y, v.z, v.w};
            float u[8];
#pragma unroll
            for (int j = 0; j < 4; ++j) { u[2 * j] = bf_lo(vw[j]); u[2 * j + 1] = bf_hi(vw[j]); sum[2 * j] += u[2 * j]; sum[2 * j + 1] += u[2 * j + 1]; }
            const float rc = (t + 1 < win) ? 1.f / (float)(t + 1) : rwin;
            u32x4 o; o.x = pk2(sum[0] * rc - u[0], sum[1] * rc - u[1]); o.y = pk2(sum[2] * rc - u[2], sum[3] * rc - u[3]);
            o.z = pk2(sum[4] * rc - u[4], sum[5] * rc - u[5]); o.w = pk2(sum[6] * rc - u[6], sum[7] * rc - u[7]);
            *(u32x4*)(DIFF + ((size_t)b * SEQ + t) * Dm + c8 * 8) = o;
            if (t - win + 1 >= 0) { const u32x4 q = *(const u32x4*)(ub + (size_t)(t - win + 1) * 4096); const unsigned qw[4] = {q.x, q.y, q.z, q.w};
#pragma unroll
                for (int j = 0; j < 4; ++j) { sum[2 * j] -= bf_lo(qw[j]); sum[2 * j + 1] -= bf_hi(qw[j]); } }
        }
    }
}

#define XB_TMO      128
#define XB_XCNT(j)  (256  + 64 * (j))
#define XB_XSUB(j)  (1280 + 64 * (j))
#define XB_XGEN(j)  (2304 + 64 * (j))
#define XB_TOP      3328
#define XB_TOPGEN   3392
#define XCD_BAR_WORDS 3456
#define XB_SPIN_CAP (1u << 20)
__device__ __forceinline__ unsigned xb_ld(unsigned* p)              { return __hip_atomic_load(p, __ATOMIC_RELAXED, __HIP_MEMORY_SCOPE_AGENT); }
__device__ __forceinline__ unsigned xb_add(unsigned* p, unsigned v) { return __hip_atomic_fetch_add(p, v, __ATOMIC_RELAXED, __HIP_MEMORY_SCOPE_AGENT); }
__device__ __forceinline__ unsigned xb_xcc_id() { return (unsigned)__builtin_amdgcn_s_getreg((3 << 11) | 20) & 0xFu; }
#define XB_SPIN(cond, bar) do { unsigned _sp = 0; while (cond) { __builtin_amdgcn_s_sleep(1); \
    if ((++_sp & 255u) == 0u) { if (xb_ld(&(bar)[XB_TMO])) break; if (_sp > XB_SPIN_CAP) { atomicAdd(&(bar)[XB_TMO], 1u); break; } } } } while (0)
struct XcdBarrier { unsigned* bar; unsigned x; volatile LAS unsigned* st; };
__device__ __forceinline__ XcdBarrier xcd_barrier_post(unsigned* bar, volatile LAS unsigned* st) {
    XcdBarrier b; b.bar = bar; b.x = xb_xcc_id(); b.st = st;
    if (threadIdx.x == 0) (void)xb_add(&bar[XB_XCNT(b.x)], 1u);
    return b;
}
__device__ __forceinline__ void xcd_barrier_complete(unsigned* bar, unsigned x, unsigned& nloc, unsigned& nx) {
    const unsigned G = gridDim.x * gridDim.y * gridDim.z;
    unsigned sum, cnt, mine, sp = 0u;
    for (;;) {
        sum = 0u; cnt = 0u; mine = 0u;
#pragma unroll
        for (unsigned j = 0; j < 16; ++j) { const unsigned c = xb_ld(&bar[XB_XCNT(j)]); sum += c; cnt += (c > 0u) ? 1u : 0u; mine = (j == x) ? c : mine; }
        if (sum == G) break;
        __builtin_amdgcn_s_sleep(1);
        if ((++sp & 255u) == 0u) { if (xb_ld(&bar[XB_TMO])) break; if (sp > XB_SPIN_CAP) { atomicAdd(&bar[XB_TMO], 1u); break; } }
    }
    nloc = mine > 0u ? mine : 1u; nx = cnt > 0u ? cnt : 1u;
}
__device__ __forceinline__ void xcd_barrier(const XcdBarrier& b) {
    asm volatile("s_waitcnt vmcnt(0)" ::: "memory");
    __syncthreads();
    if (threadIdx.x == 0) {
        unsigned* bar = b.bar;
        __builtin_amdgcn_s_waitcnt(0);
        unsigned nloc = b.st[0], nx = b.st[1];
        if (nloc == 0u) { xcd_barrier_complete(bar, b.x, nloc, nx); b.st[0] = nloc; b.st[1] = nx; }
        const unsigned old = xb_add(&bar[XB_XSUB(b.x)], 1u);
        const unsigned gen = old / nloc;
        if (old + 1u == (gen + 1u) * nloc) {
            __builtin_amdgcn_fence(__ATOMIC_RELEASE, "agent");
            asm volatile("s_waitcnt vmcnt(0)" ::: "memory");
            const unsigned og = xb_add(&bar[XB_TOP], 1u);
            const unsigned tg = og / nx;
            if (og + 1u == (tg + 1u) * nx) xb_add(&bar[XB_TOPGEN], 1u);
            else XB_SPIN(xb_ld(&bar[XB_TOPGEN]) == tg, bar);
            __builtin_amdgcn_fence(__ATOMIC_ACQUIRE, "agent");
            xb_add(&bar[XB_XGEN(b.x)], 1u);
            asm volatile("s_waitcnt vmcnt(0)" ::: "memory");
        } else {
            XB_SPIN(xb_ld(&bar[XB_XGEN(b.x)]) == gen, bar);
            __builtin_amdgcn_fence(__ATOMIC_ACQUIRE, "agent");
            asm volatile("s_waitcnt vmcnt(0)" ::: "memory");
        }
    }
    __syncthreads();
}

__global__ void __launch_bounds__(NTHR) mega_fwd(Params p) {
    extern __shared__ __attribute__((aligned(16))) unsigned char lds_raw[];
    LAS unsigned char* lds = (LAS unsigned char*)lds_raw;
    cg::grid_group grid = cg::this_grid();
    const int ph_lo = p.ph_lo, ph_hi = p.ph_hi;
    volatile LAS unsigned* xst = (volatile LAS unsigned*)(lds + LDS_BYTES);
    if (threadIdx.x == 0) { xst[0] = 0u; xst[1] = 0u; }
    __syncthreads();
    const XcdBarrier xb = xcd_barrier_post((unsigned*)(p.ws + WS_BAR), xst);
    bool first_sync = (ph_lo < 0);
    int ph = 0;
#define RUN(ty, ...) do { if (ph >= ph_lo && ph < ph_hi) { { int tid = threadIdx.x; asm volatile("" : "+v"(tid)); __VA_ARGS__; } \
        if (ph + 1 < ph_hi) { if (first_sync) { grid.sync(); first_sync = false; } else xcd_barrier(xb); } } ++ph; } while (0)
    unsigned char* ws = p.ws;
    bf16_t* Wt = (bf16_t*)(ws + WS_W);
    bf16_t* LORA = (bf16_t*)(ws + WS_LORA);
    bf16_t* VF = (bf16_t*)(ws + WS_VF); bf16_t* B1 = (bf16_t*)(ws + WS_B1); bf16_t* B2 = (bf16_t*)(ws + WS_B2); bf16_t* B3 = (bf16_t*)(ws + WS_B3);
    bf16_t* B4 = (bf16_t*)(ws + WS_B4); bf16_t* M0 = (bf16_t*)(ws + WS_M0); bf16_t* M1 = (bf16_t*)(ws + WS_M1);
    for (int L = 0; L < 4; ++L) {
        const int kind = L % 3;
        bf16_t* XSA = (bf16_t*)p.out; bf16_t* XSB = XSA + (size_t)T * Dm;
        const void* xin = (L == 0) ? (const void*)p.in[0] : (L == 2) ? (const void*)XSB : (const void*)XSA;
        const float* nw = p.in[2] + (size_t)L * Dm;
        const bf16_t* oA; const bf16_t* oB; int olda, ont;
        if (kind == 0) {
            const int ia = L / 3; const bool has_v = ia > 0;
            const float* mu = p.in[3] + (size_t)ia * 6 * Dm;
            bf16_t* Vb = has_v ? B3 : VF;
            for (int rd = 0; rd < 2; ++rd) {
                RUN(0, if (rd == 0) rwkv_weights(tid, p, ia, has_v, lds);
                    if (L == 0) norm_mix_phase<3, false>(tid, xin, nw, mu + (size_t)(3 * rd) * Dm, mu + (size_t)(3 * rd + 1) * Dm, M0, M1, mu + (size_t)(3 * rd + 2) * Dm, XSB);
                    else norm_mix_phase<3, true>(tid, xin, nw, mu + (size_t)(3 * rd) * Dm, mu + (size_t)(3 * rd + 1) * Dm, M0, M1, mu + (size_t)(3 * rd + 2) * Dm, XSB));
                RUN(1, ProbRwkvIn pr; pr.nM = T / BM; pr.nN = (rd == 0) ? (has_v ? 25 : 24) : 10; pr.nt = Dm / BK; pr.lda = Dm; pr.ldb = Dm; pr.round = rd;
                    pr.A0 = M0; pr.dA1 = M1 - M0; pr.dA2 = (long)(((const char*)XSB - (const char*)M0) / 2); pr.Wt = Wt;
                    pr.O0 = B1; pr.dO1 = B2 - B1; pr.dO2 = Vb - B1; pr.dO3 = B4 - B1; pr.lora = LORA; gemm_phase(tid, lds, pr));
            }
            RUN(2, ProbRwkvUp pu; pu.nM = T / BM; pu.nN = has_v ? 24 : 16; pu.nt = 4; pu.lda = 256; pu.ldb = 256; pu.A = LORA; pu.Bt = Wt + (size_t)11008 * 2048;
                pu.w0 = p.in[5] + (size_t)ia * Dm; pu.d_a0 = (long)((p.in[8] + (size_t)ia * Dm) - pu.w0); pu.d_v0 = (long)(p.in[16] - pu.w0); pu.E = M0; pu.AL = M1; pu.V = B3; pu.VF = VF; gemm_phase(tid, lds, pu));
            RUN(3, scan_phase(tid, lds, B1, M0, B2, Vb, M1, B4, p.in[11] + (size_t)ia * Dm, p.in[12] + (size_t)ia * Dm, p.in[13] + (size_t)ia * Dm, p.in[14] + (size_t)ia * Dm, p.in[15] + (size_t)ia * Dm, B1));
            if (has_v) { RUN(9, { const u32x4* src = (const u32x4*)XSA; u32x4* dst = (u32x4*)B2; const long n16 = (long)T * Dm / 8;
                for (long i = (long)blockIdx.x * NTHR + tid; i < n16; i += (long)gridDim.x * NTHR) dst[i] = src[i]; }); }
            oA = B1; oB = Wt + (size_t)8192 * 2048; olda = Dm; ont = Dm / BK;
        } else {
            RUN(4, if (kind == 1) attn_weights(tid, p, lds); else pool_weights(tid, p, lds); norm_mix_phase<0, true>(tid, xin, nw, nullptr, nullptr, M1, nullptr));
            RUN(5, ProbStoreBf16 ps; ps.nM = T / BM; ps.nN = (kind == 1) ? 40 : 16; ps.nt = Dm / BK; ps.lda = Dm; ps.ldb = Dm; ps.A = M1; ps.Bt = Wt; ps.O = B1; ps.ldo = (kind == 1) ? 10240 : 4096; gemm_phase(tid, lds, ps));
            if (kind == 1) {
                RUN(7, attn_phase(tid, lds, B1, (float*)(ws + WS_LSE), p.in[21], p.in[22], (const float*)(ws + WS_COS), (const float*)(ws + WS_SIN)));
                RUN(8, attn_combine_phase(tid, B1, (const float*)(ws + WS_LSE), M1));
                oA = M1; oB = Wt + (size_t)10240 * 2048; olda = 1024; ont = 1024 / BK;
            } else {
                RUN(9, pool_diff_phase(tid, B1, B3));
                RUN(10, ProbPoolGrp pg; pg.nM = T / BM; pg.nN = 8; pg.nt = 512 / BK; pg.lda = Dm; pg.ldb = 512; pg.A = B3; pg.Bt = Wt + (size_t)4096 * 2048; pg.scale = p.in[26]; pg.UG = B1; pg.Z = B4; gemm_phase(tid, lds, pg));
                oA = B4; oB = Wt + (size_t)4096 * 2048 + (size_t)2048 * 512; olda = Dm; ont = Dm / BK;
            }
        }
        RUN(11, ProbResid po; po.nM = T / BM; po.nN = 8; po.nt = ont; po.lda = olda; po.ldb = olda; po.A = oA; po.Bt = oB; po.xin = (L == 3) ? (const void*)B2 : xin; po.in_bf = (L != 0); po.xout = (L == 0) ? (void*)XSA : (L == 1) ? (void*)XSB : (L == 2) ? (void*)XSA : (void*)p.out; po.out_bf = (L != 3); gemm_phase(tid, lds, po));
    }
#undef RUN
}
constexpr int N_PHASES = 7 + 5 + 5 + 8;

extern "C" void kernel_launch(void* const* d_in, const int* in_sizes, int n_in, void* d_out, int out_size, void* d_ws, size_t ws_size, hipStream_t stream) {
    static int grid = 0;
    if (grid == 0) {
        if (n_in != 28 || ws_size < WS_END) { fprintf(stderr, "kernel_launch: unexpected n_in %d / ws_size %zu\n", n_in, ws_size); grid = -1; return; }
        int dev = 0, cus = 0, per_cu = 0;
        hipGetDevice(&dev); hipDeviceGetAttribute(&cus, hipDeviceAttributeMultiprocessorCount, dev);
        if (hipFuncSetAttribute((const void*)mega_fwd, hipFuncAttributeMaxDynamicSharedMemorySize, LDS_BYTES + 64) != hipSuccess) { fprintf(stderr, "kernel_launch: hipFuncSetAttribute failed\n"); grid = -1; return; }
        if (hipOccupancyMaxActiveBlocksPerMultiprocessor(&per_cu, (const void*)mega_fwd, NTHR, LDS_BYTES + 64) != hipSuccess || per_cu < 1) { fprintf(stderr, "kernel_launch: occupancy query failed (%d)\n", per_cu); per_cu = 1; }
        (void)hipGetLastError();
        grid = cus;
    }
    if (grid < 0) return;
    if (hipMemsetAsync((unsigned char*)d_ws + WS_BAR, 0, XCD_BAR_WORDS * 4, stream) != hipSuccess) { fprintf(stderr, "kernel_launch: memset failed\n"); return; }
    Params p{};
    for (int i = 0; i < 28; ++i) p.in[i] = (const float*)d_in[i];
    p.positions = (const int*)d_in[1]; p.out = (float*)d_out; p.ws = (unsigned char*)d_ws;
#if MK_MULTI
    for (int k = 0; k < N_PHASES; ++k) { p.ph_lo = k; p.ph_hi = k + 1; hipLaunchKernelGGL(mega_fwd, dim3(grid), dim3(NTHR), LDS_BYTES + 64, stream, p); }
#else
    p.ph_lo = 0; p.ph_hi = N_PHASES;
    void* args[] = {&p};
    hipError_t e = hipLaunchCooperativeKernel((const void*)mega_fwd, dim3(grid), dim3(NTHR), args, LDS_BYTES + 64, stream);
    if (e != hipSuccess) fprintf(stderr, "cooperative launch failed: %s (grid %d)\n", hipGetErrorString(e), grid);
#endif
}
```

```cpp
#include <hip/hip_runtime.h>
#include <hip/hip_cooperative_groups.h>
#include <cstdio>
namespace cg = cooperative_groups;

#ifndef MK_MULTI
#define MK_MULTI 0
#endif

#define LAS __attribute__((address_space(3)))
typedef unsigned short bf16_t;
typedef short bf16x8 __attribute__((ext_vector_type(8)));
typedef float f32x4 __attribute__((ext_vector_type(4)));
typedef float f32x2 __attribute__((ext_vector_type(2)));
typedef unsigned u32x4 __attribute__((ext_vector_type(4)));
typedef unsigned u32x2 __attribute__((ext_vector_type(2)));
typedef unsigned short u16x4 __attribute__((ext_vector_type(4)));

constexpr int Dm = 2048, NB = 16, SEQ = 2048, T = NB * SEQ;
constexpr float RMS_EPS = 1e-6f, LN_EPS = 64e-5f;
constexpr int NTHR = 512, NWAVE = 8;
constexpr int LDS_BYTES = 128 * 1024;
constexpr size_t MiB = 1024 * 1024;
constexpr size_t WS_W = 0;
constexpr size_t WS_LORA = 64 * MiB;
constexpr size_t WS_COS = 80 * MiB;
constexpr size_t WS_SIN = 82 * MiB;
constexpr size_t WS_LSE = 84 * MiB;
constexpr size_t WS_BAR = 88 * MiB;
constexpr size_t WS_VF = 128 * MiB;
constexpr size_t WS_B1 = 256 * MiB, WS_B2 = 384 * MiB, WS_B3 = 512 * MiB, WS_B4 = 640 * MiB, WS_M0 = 768 * MiB, WS_M1 = 896 * MiB;
constexpr size_t WS_END = 1024 * MiB;

struct Params {
    const float* in[28];
    const int* positions;
    float* out;
    unsigned char* ws;
    int ph_lo, ph_hi;
};

__device__ __forceinline__ unsigned pk2(float lo, float hi) { unsigned r; asm volatile("v_cvt_pk_bf16_f32 %0, %1, %2" : "=v"(r) : "v"(lo), "v"(hi)); return r; }
__device__ __forceinline__ float bf_lo(unsigned u) { return __uint_as_float(u << 16); }
__device__ __forceinline__ float bf_hi(unsigned u) { return __uint_as_float(u & 0xffff0000u); }
__device__ __forceinline__ unsigned pkh2(float lo, float hi) { typedef _Float16 h2 __attribute__((ext_vector_type(2))); h2 v; v.x = (_Float16)lo; v.y = (_Float16)hi; return __builtin_bit_cast(unsigned, v); }
__device__ __forceinline__ float h_lo(unsigned u) { typedef _Float16 h2 __attribute__((ext_vector_type(2))); h2 v = __builtin_bit_cast(h2, u); return (float)v.x; }
__device__ __forceinline__ float h_hi(unsigned u) { typedef _Float16 h2 __attribute__((ext_vector_type(2))); h2 v = __builtin_bit_cast(h2, u); return (float)v.y; }
__device__ __forceinline__ float wave_sum(float v) {
#pragma unroll
    for (int o = 1; o < 64; o <<= 1) v += __shfl_xor(v, o);
    return v;
}
__device__ __forceinline__ float quad_sum(float v) {
    v += __int_as_float(__builtin_amdgcn_update_dpp(0, __float_as_int(v), 0xB1, 0xF, 0xF, true));
    v += __int_as_float(__builtin_amdgcn_update_dpp(0, __float_as_int(v), 0x4E, 0xF, 0xF, true));
    return v;
}
__device__ __forceinline__ float row16_sum(float v) {
    v = quad_sum(v);
    v += __int_as_float(__builtin_amdgcn_update_dpp(0, __float_as_int(v), 0x124, 0xF, 0xF, true));
    v += __int_as_float(__builtin_amdgcn_update_dpp(0, __float_as_int(v), 0x128, 0xF, 0xF, true));
    return v;
}
__device__ __forceinline__ float sigmoidf_(float x) { return 1.f / (1.f + __expf(-x)); }
__device__ __forceinline__ float siluf_(float x) { return x / (1.f + __expf(-x)); }

constexpr int BM = 256, BK = 64, HALF = 128, HTB = HALF * BK * 2, NXCD = 8, WGM = 8;
__device__ __forceinline__ int lds_byte(int r, int c) { const int st = (r >> 4) * 2 + (c >> 5), rr = r & 15, cc = c & 31, ob = rr * 64 + cc * 2; return st * 1024 + (ob ^ (((ob >> 9) & 1) << 5)); }
__device__ __forceinline__ void stage_rc(int b, int& R, int& C) { const int st = b / 1024, sb = b % 1024, swz = sb ^ (((sb >> 9) & 1) << 5); R = (st >> 1) * 16 + swz / 64; C = (st & 1) * 32 + (swz % 64) / 2; }
__device__ __forceinline__ int perm32(int rho) { const int n = rho >> 4, i = rho & 15; return 8 * (i >> 2) + 4 * n + (i & 3); }
struct Unit { int pm, pn; };
__device__ __forceinline__ bool unit_next(int nM, int nN, int i, Unit& u) {
    const int nwg = nM * nN; const long L = (long)i * gridDim.x + blockIdx.x; if (L >= nwg) return false;
    int wgid = (int)L; { const int q = nwg / NXCD, r = nwg % NXCD, xcd = wgid % NXCD, off = wgid / NXCD; wgid = (xcd < r ? xcd * (q + 1) : r * (q + 1) + (xcd - r) * q) + off; }
    const int nig = WGM * nN, gid = wgid / nig, fm = gid * WGM, gsz = (nM - fm) < WGM ? (nM - fm) : WGM;
    u.pm = fm + ((wgid % nig) % gsz); u.pn = (wgid % nig) / gsz; return true;
}

template <class P>
__device__ __forceinline__ void gemm_phase(int tid, LAS unsigned char* lds, const P& prob) {
    const int wid = __builtin_amdgcn_readfirstlane(tid >> 6), lane = tid & 63, wr = wid >> 2, wc = wid & 3, fr = lane & 15, fq = lane >> 4;
    const int nt = prob.nt;
    unsigned voffA[2], voffB[2];
#pragma unroll
    for (int i = 0; i < 2; ++i) { int R, C; stage_rc(tid * 16 + i * 8192, R, C); const int Rb = P::PERM ? ((R & ~31) + perm32(R & 31)) : R;
        voffA[i] = (unsigned)(R * prob.lda + C) * 2u; voffB[i] = (unsigned)(Rb * prob.ldb + C) * 2u; }
    const size_t kstep = (size_t)(BK * 2);
    const size_t hstepA = (size_t)HALF * prob.lda * 2, hstepB = (size_t)HALF * prob.ldb * 2;
    const unsigned ldsw = (unsigned)wid * 1024u;
    const int aoff = lds_byte(wr * 64 + fr, fq * 8), boff = lds_byte(wc * 32 + fr, fq * 8);
#define G_SA(b, h) (((b) * 2 + (h)) * HTB)
#define G_SB(b, h) ((4 + (b) * 2 + (h)) * HTB)
#define G_STAGE(bufoff, gbase, voff) do { _Pragma("unroll") for (int _i = 0; _i < 2; ++_i) \
        __builtin_amdgcn_global_load_lds((const unsigned*)((const char*)(gbase) + (voff)[_i]), (LAS unsigned*)(lds + (bufoff) + ldsw + _i * 8192), 16, 0, 0); } while (0)
#define G_LDA(dst, b, h) do { _Pragma("unroll") for (int m = 0; m < 4; ++m) _Pragma("unroll") for (int k = 0; k < 2; ++k) dst[m][k] = *(const LAS bf16x8*)(lds + G_SA(b, h) + aoff + m * 2048 + k * 1024); } while (0)
#define G_LDB(dst, b, h) do { _Pragma("unroll") for (int n = 0; n < 2; ++n) _Pragma("unroll") for (int k = 0; k < 2; ++k) dst[n][k] = *(const LAS bf16x8*)(lds + G_SB(b, h) + boff + n * 2048 + k * 1024); } while (0)
#define G_MMA(ai, bj, At, Bt) do { __builtin_amdgcn_s_setprio(1); _Pragma("unroll") for (int m = 0; m < 4; ++m) _Pragma("unroll") for (int n = 0; n < 2; ++n) _Pragma("unroll") for (int k = 0; k < 2; ++k) \
        acc[ai][bj][m][n] = __builtin_amdgcn_mfma_f32_16x16x32_bf16(Bt[n][k], At[m][k], acc[ai][bj][m][n], 0, 0, 0); __builtin_amdgcn_s_setprio(0); } while (0)
#define G_WAIT_V(n) asm volatile("s_waitcnt vmcnt(" #n ")" ::: "memory")
#define G_WAIT_L(n) asm volatile("s_waitcnt lgkmcnt(" #n ")" ::: "memory")
#define G_BAR __builtin_amdgcn_s_barrier()
#define G_SCHED __builtin_amdgcn_sched_barrier(0)
    Unit cur, nxt; int ui = 0;
    if (!unit_next(prob.nM, prob.nN, 0, cur)) return;
    f32x4 acc[2][2][4][2];
    prob.init_acc(acc, cur, wr, wc, fr, fq);
    bf16x8 At[4][2], B0[2][2], B1[2][2];
    const char* cA = prob.a_ptr(cur); const char* cB = prob.b_ptr(cur);
    G_STAGE(G_SB(0, 0), cB, voffB); G_STAGE(G_SA(0, 0), cA, voffA); G_STAGE(G_SB(0, 1), cB + hstepB, voffB); G_STAGE(G_SA(0, 1), cA + hstepA, voffA);
    if (wr == 1) G_BAR;
    G_WAIT_V(4); G_BAR;
    G_STAGE(G_SB(1, 0), cB + kstep, voffB); G_STAGE(G_SA(1, 0), cA + kstep, voffA); G_STAGE(G_SB(1, 1), cB + hstepB + kstep, voffB);
    G_WAIT_V(6); G_BAR;
    for (;;) {
        const bool has_next = unit_next(prob.nM, prob.nN, ui + 1, nxt);
        const char* nA = has_next ? prob.a_ptr(nxt) : cA; const char* nB = has_next ? prob.b_ptr(nxt) : cB;
        for (int t = 0; t < nt; t += 2) {
            const bool last = (t == nt - 2);
            const char* a1 = cA + (size_t)(t + 1) * kstep;
            const char* a2 = last ? nA : cA + (size_t)(t + 2) * kstep; const char* b2 = last ? nB : cB + (size_t)(t + 2) * kstep;
            const char* a3 = a2 + kstep; const char* b3 = b2 + kstep;
            G_LDB(B0, 0, 0); G_SCHED; G_LDA(At, 0, 0); G_STAGE(G_SA(1, 1), a1 + hstepA, voffA);
            G_WAIT_L(8); G_BAR; G_WAIT_L(0); G_MMA(0, 0, At, B0); G_BAR; G_SCHED;
            G_LDB(B1, 0, 1); G_STAGE(G_SB(0, 0), b2, voffB);
            G_BAR; G_WAIT_L(0); G_MMA(0, 1, At, B1); G_BAR;
            G_LDA(At, 0, 1); G_STAGE(G_SA(0, 0), a2, voffA);
            G_BAR; G_WAIT_L(0); G_MMA(1, 0, At, B0); G_BAR; G_SCHED;
            G_STAGE(G_SB(0, 1), b2 + hstepB, voffB);
            G_WAIT_V(6); G_BAR; G_MMA(1, 1, At, B1); G_BAR;
            G_LDB(B0, 1, 0); G_SCHED; G_LDA(At, 1, 0); G_STAGE(G_SA(0, 1), a2 + hstepA, voffA);
            G_WAIT_L(8); G_BAR; G_WAIT_L(0); G_MMA(0, 0, At, B0); G_BAR; G_SCHED;
            G_LDB(B1, 1, 1); G_STAGE(G_SB(1, 0), b3, voffB);
            G_BAR; G_WAIT_L(0); G_MMA(0, 1, At, B1); G_BAR;
            G_LDA(At, 1, 1); G_STAGE(G_SA(1, 0), a3, voffA);
            G_BAR; G_WAIT_L(0); G_MMA(1, 0, At, B0); G_BAR; G_SCHED;
            G_STAGE(G_SB(1, 1), b3 + hstepB, voffB);
            G_WAIT_V(6); G_BAR; G_MMA(1, 1, At, B1); G_BAR;
        }
        prob.epi(acc, cur, wr, wc, fr, fq);
        if (!has_next) break;
        prob.init_acc(acc, nxt, wr, wc, fr, fq);
        cur = nxt; cA = nA; cB = nB; ++ui;
    }
    G_WAIT_V(0);
    if (wr == 0) G_BAR;
    G_BAR;
#undef G_SA
#undef G_SB
#undef G_STAGE
#undef G_LDA
#undef G_LDB
#undef G_MMA
#undef G_WAIT_V
#undef G_WAIT_L
#undef G_BAR
#undef G_SCHED
}

#define EPI_ROWS(u) const int row0 = (u).pm * BM + wr * 64 + fr
#define EPI_FOR_RM _Pragma("unroll") for (int ai = 0; ai < 2; ++ai) _Pragma("unroll") for (int m = 0; m < 4; ++m)

#define PK8(v0, v1) ((u32x4){pk2((v0)[0], (v0)[1]), pk2((v0)[2], (v0)[3]), pk2((v1)[0], (v1)[1]), pk2((v1)[2], (v1)[3])})
struct ProbStoreBf16 {
    static constexpr bool PERM = true;
    int nM, nN, nt, lda, ldb;
    const bf16_t* A; const bf16_t* Bt; bf16_t* O; int ldo;
    __device__ __forceinline__ void init_acc(f32x4 (&acc)[2][2][4][2], const Unit&, int, int, int, int) const {
#pragma unroll
        for (int a = 0; a < 2; ++a)
#pragma unroll
            for (int b = 0; b < 2; ++b)
#pragma unroll
                for (int m = 0; m < 4; ++m)
#pragma unroll
                    for (int n = 0; n < 2; ++n) acc[a][b][m][n] = (f32x4){0.f, 0.f, 0.f, 0.f};
    }
    __device__ __forceinline__ const char* a_ptr(const Unit& u) const { return (const char*)(A + (size_t)u.pm * BM * lda); }
    __device__ __forceinline__ const char* b_ptr(const Unit& u) const { return (const char*)(Bt + (size_t)u.pn * BM * ldb); }
    __device__ __forceinline__ void epi(const f32x4 (&acc)[2][2][4][2], const Unit& u, int wr, int wc, int fr, int fq) const {
        EPI_ROWS(u); const int col0 = u.pn * BM + wc * 32 + 8 * fq;
        EPI_FOR_RM { bf16_t* rowp = O + (size_t)(row0 + ai * HALF + m * 16) * ldo + col0;
#pragma unroll
            for (int bj = 0; bj < 2; ++bj) { const f32x4 v0 = acc[ai][bj][m][0], v1 = acc[ai][bj][m][1];
                u32x4 o; o.x = pk2(v0[0], v0[1]); o.y = pk2(v0[2], v0[3]); o.z = pk2(v1[0], v1[1]); o.w = pk2(v1[2], v1[3]);
                *(u32x4*)(rowp + bj * HALF) = o; } }
    }
};
struct ProbResid {
    static constexpr bool PERM = true;
    int nM, nN, nt, lda, ldb;
    const bf16_t* A; const bf16_t* Bt; const void* xin; void* xout; int in_bf, out_bf;
    __device__ __forceinline__ void init_acc(f32x4 (&acc)[2][2][4][2], const Unit& u, int wr, int wc, int fr, int fq) const {
        EPI_ROWS(u); const int col0 = u.pn * BM + wc * 32 + 8 * fq;
        if (in_bf) {
#pragma unroll
            for (int ai = 0; ai < 2; ++ai)
#pragma unroll
                for (int bj = 0; bj < 2; ++bj)
#pragma unroll
                    for (int m = 0; m < 4; ++m) { const u32x4 r = *(const u32x4*)((const bf16_t*)xin + (size_t)(row0 + ai * HALF + m * 16) * Dm + col0 + bj * HALF);
                        acc[ai][bj][m][0] = (f32x4){bf_lo(r.x), bf_hi(r.x), bf_lo(r.y), bf_hi(r.y)}; acc[ai][bj][m][1] = (f32x4){bf_lo(r.z), bf_hi(r.z), bf_lo(r.w), bf_hi(r.w)}; }
        } else {
#pragma unroll
            for (int ai = 0; ai < 2; ++ai)
#pragma unroll
                for (int bj = 0; bj < 2; ++bj)
#pragma unroll
                    for (int m = 0; m < 4; ++m)
#pragma unroll
                        for (int n = 0; n < 2; ++n) acc[ai][bj][m][n] = *(const f32x4*)((const float*)xin + (size_t)(row0 + ai * HALF + m * 16) * Dm + col0 + bj * HALF + 4 * n);
        }
    }
    __device__ __forceinline__ const char* a_ptr(const Unit& u) const { return (const char*)(A + (size_t)u.pm * BM * lda); }
    __device__ __forceinline__ const char* b_ptr(const Unit& u) const { return (const char*)(Bt + (size_t)u.pn * BM * ldb); }
    __device__ __forceinline__ void epi(const f32x4 (&acc)[2][2][4][2], const Unit& u, int wr, int wc, int fr, int fq) const {
        EPI_ROWS(u); const int col0 = u.pn * BM + wc * 32 + 8 * fq;
        if (out_bf) {
            EPI_FOR_RM { const size_t ro = (size_t)(row0 + ai * HALF + m * 16) * Dm + col0;
#pragma unroll
                for (int bj = 0; bj < 2; ++bj) *(u32x4*)((bf16_t*)xout + ro + bj * HALF) = PK8(acc[ai][bj][m][0], acc[ai][bj][m][1]); }
        } else {
            EPI_FOR_RM { const size_t ro = (size_t)(row0 + ai * HALF + m * 16) * Dm + col0;
#pragma unroll
                for (int bj = 0; bj < 2; ++bj)
#pragma unroll
                    for (int n = 0; n < 2; ++n) *(f32x4*)((float*)xout + ro + bj * HALF + 4 * n) = acc[ai][bj][m][n]; }
        }
    }
};
struct ProbRwkvIn {
    static constexpr bool PERM = true;
    int nM, nN, nt, lda, ldb;
    int round;
    const bf16_t* A0; long dA1, dA2;
    const bf16_t* Wt;
    bf16_t* O0; long dO1, dO2, dO3; bf16_t* lora;
    __device__ __forceinline__ void init_acc(f32x4 (&acc)[2][2][4][2], const Unit&, int, int, int, int) const {
#pragma unroll
        for (int a = 0; a < 2; ++a)
#pragma unroll
            for (int b = 0; b < 2; ++b)
#pragma unroll
                for (int m = 0; m < 4; ++m)
#pragma unroll
                    for (int n = 0; n < 2; ++n) acc[a][b][m][n] = (f32x4){0.f, 0.f, 0.f, 0.f};
    }
    __device__ __forceinline__ int mixsel(const Unit& u) const { return (round == 0) ? ((u.pn == 24) ? 2 : (u.pn >> 3)) : ((u.pn < 8) ? 0 : (u.pn == 8) ? 1 : 2); }
    __device__ __forceinline__ bool is_lora(const Unit& u) const { return (round == 0) ? (u.pn == 24) : (u.pn >= 8); }
    __device__ __forceinline__ const char* a_ptr(const Unit& u) const {
        const int j = mixsel(u);
        return (const char*)(A0 + ((j == 1) ? dA1 : (j == 2) ? dA2 : 0L) + (size_t)u.pm * BM * lda); }
    __device__ __forceinline__ const char* b_ptr(const Unit& u) const {
        size_t rowoff;
        if (round == 0) rowoff = (u.pn == 24) ? (size_t)(10240 + 512) : (size_t)u.pn * BM;
        else rowoff = (u.pn < 8) ? (size_t)(6144 + u.pn * BM) : (size_t)(10240 + (u.pn - 8) * BM);
        return (const char*)(Wt + rowoff * 2048); }
    __device__ __forceinline__ void epi(const f32x4 (&acc)[2][2][4][2], const Unit& u, int wr, int wc, int fr, int fq) const {
        EPI_ROWS(u);
        if (is_lora(u)) {
            const int lim = (round == 0) ? 64 : 96, cb = (round == 0) ? 192 : (u.pn - 8) * 96; const bool th = (round == 1 && u.pn == 8);
            const int c = wc * 32 + 8 * fq;
            if (c < lim) {
                if (th) {
                    EPI_FOR_RM { bf16_t* rowp = lora + (size_t)(row0 + ai * HALF + m * 16) * 256 + cb + c; f32x4 a = acc[ai][0][m][0], b = acc[ai][0][m][1];
#pragma unroll
                        for (int j = 0; j < 4; ++j) { a[j] = 1.f - 2.f / (__expf(2.f * a[j]) + 1.f); b[j] = 1.f - 2.f / (__expf(2.f * b[j]) + 1.f); }
                        *(u32x4*)rowp = PK8(a, b); }
                } else {
                    EPI_FOR_RM { bf16_t* rowp = lora + (size_t)(row0 + ai * HALF + m * 16) * 256 + cb + c; const f32x4 a = acc[ai][0][m][0], b = acc[ai][0][m][1];
                        *(u32x4*)rowp = PK8(a, b); }
                }
            }
            return;
        }
        const int j = (round == 0) ? (u.pn >> 3) : 3;
        bf16_t* O = O0 + ((j == 1) ? dO1 : (j == 2) ? dO2 : (j == 3) ? dO3 : 0L); const int col0 = (u.pn & 7) * BM + wc * 32 + 8 * fq;
        EPI_FOR_RM { bf16_t* rowp = O + (size_t)(row0 + ai * HALF + m * 16) * Dm + col0;
#pragma unroll
            for (int bj = 0; bj < 2; ++bj) *(u32x4*)(rowp + bj * HALF) = PK8(acc[ai][bj][m][0], acc[ai][bj][m][1]); }
    }
};
struct ProbRwkvUp {
    static constexpr bool PERM = true;
    int nM, nN, nt, lda, ldb;
    const bf16_t* A; const bf16_t* Bt;
    const float* w0; long d_a0, d_v0;
    bf16_t* E; bf16_t* AL; bf16_t* V; const bf16_t* VF;
    __device__ __forceinline__ void init_acc(f32x4 (&acc)[2][2][4][2], const Unit& u, int wr, int wc, int fr, int fq) const {
        const int kind = u.pn >> 3; const int col0 = (u.pn & 7) * BM + wc * 32 + 8 * fq;
        const float* bias = w0 + (kind == 1 ? d_a0 : kind == 2 ? d_v0 : 0L);
#pragma unroll
        for (int b = 0; b < 2; ++b)
#pragma unroll
            for (int n = 0; n < 2; ++n) { const f32x4 bvv = *(const f32x4*)(bias + col0 + b * HALF + 4 * n);
#pragma unroll
                for (int a = 0; a < 2; ++a)
#pragma unroll
                    for (int m = 0; m < 4; ++m) acc[a][b][m][n] = bvv; }
    }
    __device__ __forceinline__ const char* a_ptr(const Unit& u) const { return (const char*)(A + (size_t)u.pm * BM * lda); }
    __device__ __forceinline__ const char* b_ptr(const Unit& u) const { return (const char*)(Bt + (size_t)u.pn * BM * ldb); }
    __device__ __forceinline__ void epi(const f32x4 (&acc)[2][2][4][2], const Unit& u, int wr, int wc, int fr, int fq) const {
        EPI_ROWS(u); const int kind = u.pn >> 3; const int col0 = (u.pn & 7) * BM + wc * 32 + 8 * fq;
        if (kind == 0) {
            EPI_FOR_RM { const size_t ro = (size_t)(row0 + ai * HALF + m * 16) * Dm + col0;
#pragma unroll
                for (int bj = 0; bj < 2; ++bj) { f32x4 a = acc[ai][bj][m][0], b = acc[ai][bj][m][1];
#pragma unroll
                    for (int j = 0; j < 4; ++j) { a[j] = 0.6065306597126334f * sigmoidf_(a[j]); b[j] = 0.6065306597126334f * sigmoidf_(b[j]); }
                    u32x4 o; o.x = pkh2(a[0], a[1]); o.y = pkh2(a[2], a[3]); o.z = pkh2(b[0], b[1]); o.w = pkh2(b[2], b[3]);
                    *(u32x4*)(E + ro + bj * HALF) = o; } }
        } else if (kind == 1) {
            EPI_FOR_RM { const size_t ro = (size_t)(row0 + ai * HALF + m * 16) * Dm + col0;
#pragma unroll
                for (int bj = 0; bj < 2; ++bj) { f32x4 a = acc[ai][bj][m][0], b = acc[ai][bj][m][1];
#pragma unroll
                    for (int j = 0; j < 4; ++j) { a[j] = sigmoidf_(a[j]); b[j] = sigmoidf_(b[j]); }
                    u32x4 o; o.x = pkh2(a[0], a[1]); o.y = pkh2(a[2], a[3]); o.z = pkh2(b[0], b[1]); o.w = pkh2(b[2], b[3]);
                    *(u32x4*)(AL + ro + bj * HALF) = o; } }
        } else {
            EPI_FOR_RM { const size_t ro = (size_t)(row0 + ai * HALF + m * 16) * Dm + col0;
#pragma unroll
                for (int bj = 0; bj < 2; ++bj) { f32x4 a = acc[ai][bj][m][0], b = acc[ai][bj][m][1];
                    const u32x4 vv = *(const u32x4*)(V + ro + bj * HALF), vf = *(const u32x4*)(VF + ro + bj * HALF);
                    u32x4 o;
                    { const float p0 = bf_lo(vv.x), p1 = bf_hi(vv.x); o.x = pk2(p0 + (bf_lo(vf.x) - p0) * sigmoidf_(a[0]), p1 + (bf_hi(vf.x) - p1) * sigmoidf_(a[1])); }
                    { const float p0 = bf_lo(vv.y), p1 = bf_hi(vv.y); o.y = pk2(p0 + (bf_lo(vf.y) - p0) * sigmoidf_(a[2]), p1 + (bf_hi(vf.y) - p1) * sigmoidf_(a[3])); }
                    { const float p0 = bf_lo(vv.z), p1 = bf_hi(vv.z); o.z = pk2(p0 + (bf_lo(vf.z) - p0) * sigmoidf_(b[0]), p1 + (bf_hi(vf.z) - p1) * sigmoidf_(b[1])); }
                    { const float p0 = bf_lo(vv.w), p1 = bf_hi(vv.w); o.w = pk2(p0 + (bf_lo(vf.w) - p0) * sigmoidf_(b[2]), p1 + (bf_hi(vf.w) - p1) * sigmoidf_(b[3])); }
                    *(u32x4*)(V + ro + bj * HALF) = o; } }
        }
    }
};
struct ProbPoolGrp {
    static constexpr bool PERM = true;
    int nM, nN, nt, lda, ldb;
    const bf16_t* A; const bf16_t* Bt; const float* scale; const bf16_t* UG; bf16_t* Z;
    __device__ __forceinline__ void init_acc(f32x4 (&acc)[2][2][4][2], const Unit&, int, int, int, int) const {
#pragma unroll
        for (int a = 0; a < 2; ++a)
#pragma unroll
            for (int b = 0; b < 2; ++b)
#pragma unroll
                for (int m = 0; m < 4; ++m)
#pragma unroll
                    for (int n = 0; n < 2; ++n) acc[a][b][m][n] = (f32x4){0.f, 0.f, 0.f, 0.f};
    }
    __device__ __forceinline__ const char* a_ptr(const Unit& u) const { return (const char*)(A + (size_t)u.pm * BM * lda + (u.pn >> 1) * 512); }
    __device__ __forceinline__ const char* b_ptr(const Unit& u) const { return (const char*)(Bt + (size_t)u.pn * BM * ldb); }
    __device__ __forceinline__ void epi(const f32x4 (&acc)[2][2][4][2], const Unit& u, int wr, int wc, int fr, int fq) const {
        EPI_ROWS(u); const int col0 = u.pn * BM + wc * 32 + 8 * fq;
        f32x4 sv[2][2];
#pragma unroll
        for (int bj = 0; bj < 2; ++bj) { sv[bj][0] = *(const f32x4*)(scale + col0 + bj * HALF); sv[bj][1] = *(const f32x4*)(scale + col0 + bj * HALF + 4); }
        EPI_FOR_RM { const size_t r = (size_t)(row0 + ai * HALF + m * 16);
#pragma unroll
            for (int bj = 0; bj < 2; ++bj) { const f32x4 v0 = acc[ai][bj][m][0] * sv[bj][0], v1 = acc[ai][bj][m][1] * sv[bj][1];
                const u32x4 gg = *(const u32x4*)(UG + r * 4096 + 2048 + col0 + bj * HALF);
                u32x4 o; o.x = pk2(v0[0] * siluf_(bf_lo(gg.x)), v0[1] * siluf_(bf_hi(gg.x))); o.y = pk2(v0[2] * siluf_(bf_lo(gg.y)), v0[3] * siluf_(bf_hi(gg.y)));
                o.z = pk2(v1[0] * siluf_(bf_lo(gg.z)), v1[1] * siluf_(bf_hi(gg.z))); o.w = pk2(v1[2] * siluf_(bf_lo(gg.w)), v1[3] * siluf_(bf_hi(gg.w)));
                *(u32x4*)(Z + r * Dm + col0 + bj * HALF) = o; } }
    }
};

__device__ __forceinline__ void transpose_item(const float* W, int sld, int N, bf16_t* WT, int dld, LAS float* scr, int item, int lane) {
    const int nblk = N / 32, kb = item / nblk, nb = item % nblk, k0 = 64 * kb, n0 = 32 * nb;
#pragma unroll 8
    for (int i = 0; i < 32; ++i) { const int kk = 2 * i + (lane >> 5); scr[kk * 33 + (lane & 31)] = W[(size_t)(k0 + kk) * sld + n0 + (lane & 31)]; }
    __builtin_amdgcn_fence(__ATOMIC_RELEASE, "wavefront"); __builtin_amdgcn_wave_barrier();
    const int c = lane & 7;
#pragma unroll
    for (int j = 0; j < 4; ++j) { const int n = (lane >> 3) + 8 * j; const LAS float* s = scr + (8 * c) * 33 + n;
        u32x4 o; o.x = pk2(s[0 * 33], s[1 * 33]); o.y = pk2(s[2 * 33], s[3 * 33]); o.z = pk2(s[4 * 33], s[5 * 33]); o.w = pk2(s[6 * 33], s[7 * 33]);
        *(u32x4*)(WT + (size_t)(n0 + n) * dld + k0 + 8 * c) = o; }
    __builtin_amdgcn_fence(__ATOMIC_RELEASE, "wavefront"); __builtin_amdgcn_wave_barrier();
}
struct TrJob { const float* W; int K, N, sld; bf16_t* WT; int dld; };
template <int NJ>
__device__ __forceinline__ void run_transposes(int tid, const TrJob (&jobs)[NJ], LAS unsigned char* lds) {
    const int wave = tid >> 6, lane = tid & 63, gw = blockIdx.x * NWAVE + wave, NGW = gridDim.x * NWAVE;
    LAS float* scr = (LAS float*)(lds + wave * 8448);
    int total = 0;
#pragma unroll
    for (int j = 0; j < NJ; ++j) total += (jobs[j].K / 64) * (jobs[j].N / 32);
    for (int it = gw; it < total; it += NGW) {
        int r = it;
#pragma unroll
        for (int j = 0; j < NJ; ++j) { const int cnt = (jobs[j].K / 64) * (jobs[j].N / 32);
            if (r >= 0 && r < cnt) transpose_item(jobs[j].W, jobs[j].sld, jobs[j].N, jobs[j].WT, jobs[j].dld, scr, r, lane);
            r -= cnt; }
    }
}

__device__ __forceinline__ void rwkv_weights(int tid, const Params& p, int ia, bool has_v, LAS unsigned char* lds) {
    bf16_t* Wt = (bf16_t*)(p.ws + WS_W);
    const float* win = p.in[4] + (size_t)ia * 4 * Dm * Dm;
    TrJob jobs[5];
#pragma unroll
    for (int j = 0; j < 4; ++j) jobs[j] = TrJob{win + (size_t)j * Dm * Dm, Dm, Dm, Dm, Wt + (size_t)j * Dm * Dm, Dm};
    jobs[4] = TrJob{p.in[19] + (size_t)ia * Dm * Dm, Dm, Dm, Dm, Wt + (size_t)8192 * 2048, Dm};
    run_transposes<5>(tid, jobs, lds);
    const float* w1 = p.in[6] + (size_t)ia * Dm * 96; const float* w2 = p.in[7] + (size_t)ia * 96 * Dm;
    const float* a1 = p.in[9] + (size_t)ia * Dm * 96; const float* a2 = p.in[10] + (size_t)ia * 96 * Dm;
    const float* v1 = p.in[17]; const float* v2 = p.in[18];
    bf16_t* Wd = Wt + (size_t)10240 * 2048; bf16_t* Wu = Wt + (size_t)11008 * 2048;
    const long gt = (long)blockIdx.x * NTHR + tid, GT = (long)gridDim.x * NTHR;
    const int ndt = has_v ? 3 : 2;
    for (long i = gt; i < (long)ndt * 256 * 256; i += GT) {
        const int n = (int)(i & 255), k8 = (int)((i >> 8) & 255), tile = (int)(i >> 16);
        const float* src = tile == 0 ? w1 : tile == 1 ? a1 : v1; const int rank = tile == 2 ? 64 : 96;
        float v[8];
#pragma unroll
        for (int j = 0; j < 8; ++j) v[j] = (n < rank) ? src[(size_t)(k8 * 8 + j) * rank + n] : 0.f;
        u32x4 o; o.x = pk2(v[0], v[1]); o.y = pk2(v[2], v[3]); o.z = pk2(v[4], v[5]); o.w = pk2(v[6], v[7]);
        *(u32x4*)(Wd + ((size_t)tile * 256 + n) * 2048 + k8 * 8) = o;
    }
    const int nup = has_v ? 6144 : 4096;
    for (long i = gt; i < (long)nup * 32; i += GT) {
        const int n = (int)(i % nup), k8 = (int)(i / nup), kind = n >> 11, nn = n & 2047;
        const float* src = kind == 0 ? w2 : kind == 1 ? a2 : v2; const int klo = kind * 96, rank = kind == 2 ? 64 : 96;
        float v[8];
#pragma unroll
        for (int j = 0; j < 8; ++j) { const int k = k8 * 8 + j - klo; v[j] = (k >= 0 && k < rank) ? src[(size_t)k * Dm + nn] : 0.f; }
        u32x4 o; o.x = pk2(v[0], v[1]); o.y = pk2(v[2], v[3]); o.z = pk2(v[4], v[5]); o.w = pk2(v[6], v[7]);
        *(u32x4*)(Wu + (size_t)n * 256 + k8 * 8) = o;
    }
}
template <bool XBF> __device__ __forceinline__ void ldrow8(const void* x, size_t t, int ck, f32x4& a, f32x4& b) {
    if (XBF) { const u32x4 r = __builtin_nontemporal_load((const u32x4*)((const bf16_t*)x + t * Dm) + ck);
        a = (f32x4){bf_lo(r.x), bf_hi(r.x), bf_lo(r.y), bf_hi(r.y)}; b = (f32x4){bf_lo(r.z), bf_hi(r.z), bf_lo(r.w), bf_hi(r.w)}; }
    else { const f32x4* p_ = (const f32x4*)((const float*)x + t * Dm) + 2 * ck; a = __builtin_nontemporal_load(p_); b = __builtin_nontemporal_load(p_ + 1); }
}
__device__ __forceinline__ float sq8(const f32x4& a, const f32x4& b) { return ((a.x * a.x + a.y * a.y) + (a.z * a.z + a.w * a.w)) + ((b.x * b.x + b.y * b.y) + (b.z * b.z + b.w * b.w)); }
template <int NMIX, bool XBF>
__device__ __forceinline__ void norm_mix_phase(int tid, const void* x, const float* nw, const float* mu0, const float* mu1, bf16_t* O0, bf16_t* O1, const float* mu2 = nullptr, bf16_t* O2 = nullptr) {
    const int wave = tid >> 6, lane = tid & 63, gw = blockIdx.x * NWAVE + wave, NGW = gridDim.x * NWAVE;
    for (int ch = gw; ch < T / 16; ch += NGW) {
        const int t0 = ch * 16;
        f32x4 hp[4][2];
        if (NMIX) {
            if ((t0 % SEQ) != 0) {
                float s = 0.f;
#pragma unroll
                for (int j = 0; j < 4; ++j) { ldrow8<XBF>(x, (size_t)(t0 - 1), lane + 64 * j, hp[j][0], hp[j][1]); s += sq8(hp[j][0], hp[j][1]); }
                const float rstd = rsqrtf(wave_sum(s) * (1.f / Dm) + RMS_EPS);
#pragma unroll
                for (int j = 0; j < 4; ++j) { hp[j][0] = hp[j][0] * rstd * ((const f32x4*)nw)[2 * (lane + 64 * j)]; hp[j][1] = hp[j][1] * rstd * ((const f32x4*)nw)[2 * (lane + 64 * j) + 1]; }
            } else {
#pragma unroll
                for (int j = 0; j < 4; ++j) { hp[j][0] = (f32x4){0.f, 0.f, 0.f, 0.f}; hp[j][1] = hp[j][0]; }
            }
        }
        f32x4 xn[4][2];
#pragma unroll
        for (int j = 0; j < 4; ++j) ldrow8<XBF>(x, (size_t)t0, lane + 64 * j, xn[j][0], xn[j][1]);
        for (int r = 0; r < 16; ++r) {
            const int t = t0 + r;
            f32x4 h[4][2]; float s = 0.f;
#pragma unroll
            for (int j = 0; j < 4; ++j) { h[j][0] = xn[j][0]; h[j][1] = xn[j][1]; s += sq8(h[j][0], h[j][1]); }
            if (r + 1 < 16) {
#pragma unroll
                for (int j = 0; j < 4; ++j) ldrow8<XBF>(x, (size_t)(t + 1), lane + 64 * j, xn[j][0], xn[j][1]); }
            const float rstd = rsqrtf(wave_sum(s) * (1.f / Dm) + RMS_EPS);
#pragma unroll
            for (int j = 0; j < 4; ++j) { h[j][0] = h[j][0] * rstd * ((const f32x4*)nw)[2 * (lane + 64 * j)]; h[j][1] = h[j][1] * rstd * ((const f32x4*)nw)[2 * (lane + 64 * j) + 1]; }
            if (NMIX) {
#pragma unroll
                for (int j = 0; j < 4; ++j) {
                    const int ck = lane + 64 * j;
                    const f32x4 d0 = hp[j][0] - h[j][0], d1 = hp[j][1] - h[j][1];
                    const f32x4 a0 = h[j][0] + d0 * ((const f32x4*)mu0)[2 * ck], a1 = h[j][1] + d1 * ((const f32x4*)mu0)[2 * ck + 1];
                    const f32x4 b0 = h[j][0] + d0 * ((const f32x4*)mu1)[2 * ck], b1 = h[j][1] + d1 * ((const f32x4*)mu1)[2 * ck + 1];
                    *((u32x4*)(O0 + (size_t)t * Dm) + ck) = PK8(a0, a1); *((u32x4*)(O1 + (size_t)t * Dm) + ck) = PK8(b0, b1);
                    if (NMIX == 3) { const f32x4 c0 = h[j][0] + d0 * ((const f32x4*)mu2)[2 * ck], c1 = h[j][1] + d1 * ((const f32x4*)mu2)[2 * ck + 1]; *((u32x4*)(O2 + (size_t)t * Dm) + ck) = PK8(c0, c1); }
                    hp[j][0] = h[j][0]; hp[j][1] = h[j][1];
                }
            } else {
#pragma unroll
                for (int j = 0; j < 4; ++j) *((u32x4*)(O0 + (size_t)t * Dm) + lane + 64 * j) = PK8(h[j][0], h[j][1]);
            }
        }
    }
}

constexpr int TC = 16, NCH = SEQ / TC;
constexpr int SC_OPS = 0, SC_VP = 2 * 5 * TC * 64 * 4, SC_BON = SC_VP + 3 * TC * 64 * 4, SC_YB = SC_BON + 3 * TC * 4 + 64, SC_PAIR = SC_YB + 2 * TC * 64 * 4;
static_assert(2 * SC_PAIR <= LDS_BYTES, "scan LDS");
struct ScanOps { f32x4 w[4], a[4], b[4], k[4], r[4]; f32x2 v; };
#define SC_PAIROF(arr, cp) (((cp) & 1) ? __builtin_shufflevector(arr[(cp) >> 1], arr[(cp) >> 1], 2, 3) : __builtin_shufflevector(arr[(cp) >> 1], arr[(cp) >> 1], 0, 1))
#define SC_LOAD(O, s_) do { _Pragma("unroll") for (int q = 0; q < 4; ++q) { O.w[q] = *(const LAS f32x4*)(ob + 0 * TC * 64 + (s_) * 64 + 4 * q); O.a[q] = *(const LAS f32x4*)(ob + 1 * TC * 64 + (s_) * 64 + 4 * q); \
        O.b[q] = *(const LAS f32x4*)(ob + 2 * TC * 64 + (s_) * 64 + 4 * q); O.k[q] = *(const LAS f32x4*)(ob + 3 * TC * 64 + (s_) * 64 + 4 * q); O.r[q] = *(const LAS f32x4*)(ob + 4 * TC * 64 + (s_) * 64 + 4 * q); } \
        O.v = *(const LAS f32x2*)(vb + (s_) * 64); } while (0)
#define SC_STEP(O, s_) do { float sa[2], y[2]; \
        _Pragma("unroll") for (int i = 0; i < 2; ++i) { f32x2 t = S2[i][0] * SC_PAIROF(O.a, 0); \
            _Pragma("unroll") for (int cp = 1; cp < 8; ++cp) t = S2[i][cp] * SC_PAIROF(O.a, cp) + t; \
            sa[i] = quad_sum(t.x + t.y); } \
        _Pragma("unroll") for (int i = 0; i < 2; ++i) { const f32x2 sav = (f32x2){sa[i], sa[i]}, vv = (f32x2){O.v[i], O.v[i]}; f32x2 t; \
            _Pragma("unroll") for (int cp = 0; cp < 8; ++cp) { f32x2 u = sav * SC_PAIROF(O.b, cp); u = vv * SC_PAIROF(O.k, cp) + u; S2[i][cp] = S2[i][cp] * SC_PAIROF(O.w, cp) + u; \
                t = (cp == 0) ? S2[i][0] * SC_PAIROF(O.r, 0) : S2[i][cp] * SC_PAIROF(O.r, cp) + t; } \
            y[i] = quad_sum(t.x + t.y); } \
        if (jg == 0) *(LAS f32x2*)(yb + (s_) * 64) = (f32x2){y[0], y[1]}; } while (0)
__device__ __forceinline__ void scan_phase(int tid, LAS unsigned char* lds, const bf16_t* R, const bf16_t* E, const bf16_t* Kb, const bf16_t* V, const bf16_t* AL, const bf16_t* G,
                                           const float* k_k, const float* k_a, const float* r_k, const float* lnw, const float* lnb, bf16_t* Z) {
    const int wave = __builtin_amdgcn_readfirstlane(tid >> 6), lane = tid & 63;
    const int role = (wave < 4) ? 0 : (wave < 6) ? 1 : 2, pi = (wave < 4) ? (wave >> 1) : (wave & 1), hf = wave & 1;
    LAS unsigned char* base = lds + pi * SC_PAIR;
    LAS float* OPS = (LAS float*)(base + SC_OPS); LAS float* VP = (LAS float*)(base + SC_VP); LAS float* BON = (LAS float*)(base + SC_BON); LAS float* YB = (LAS float*)(base + SC_YB);
    for (int pb = blockIdx.x * 2; pb < NB * 32; pb += gridDim.x * 2) {
        const int pair = pb + pi, b = pair >> 5, h = pair & 31;
        const size_t gbase = (size_t)b * SEQ * Dm + h * 64;
        const int st = lane >> 2, cgp = lane & 3;
        const int ig = lane >> 2, jg = lane & 3;
        if (role == 0) {
            f32x2 S2[2][8];
#pragma unroll
            for (int i = 0; i < 2; ++i)
#pragma unroll
                for (int c = 0; c < 8; ++c) S2[i][c] = (f32x2){0.f, 0.f};
            for (int it = 0; it < NCH + 2; ++it) {
                if (it >= 1 && it <= NCH) {
                    const int c_ = it - 1;
                    const LAS float* ob = OPS + (c_ & 1) * (5 * TC * 64) + 16 * jg;
                    const LAS float* vb = VP + (c_ % 3) * (TC * 64) + 32 * hf + 2 * ig;
                    LAS float* yb = YB + (c_ & 1) * (TC * 64) + 32 * hf + 2 * ig;
                    ScanOps OA, OB;
                    SC_LOAD(OA, 0);
#pragma unroll 1
                    for (int s = 0; s < TC; s += 2) {
                        SC_LOAD(OB, s + 1);
                        SC_STEP(OA, s);
                        if (s + 2 < TC) SC_LOAD(OA, s + 2);
                        SC_STEP(OB, s + 1);
                    }
                }
                __syncthreads();
            }
        } else if (role == 1) {
            float ckk[16], cka[16], crk[16];
            u32x4 raw[10];
#pragma unroll
            for (int c = 0; c < 16; ++c) { ckk[c] = k_k[h * 64 + 16 * cgp + c]; cka[c] = k_a[h * 64 + 16 * cgp + c]; crk[c] = r_k[h * 64 + 16 * cgp + c]; }
            const size_t go = gbase + (size_t)st * Dm + 16 * cgp;
            raw[0] = *(const u32x4*)(R + go); raw[1] = *(const u32x4*)(R + go + 8); raw[2] = *(const u32x4*)(Kb + go); raw[3] = *(const u32x4*)(Kb + go + 8);
            raw[4] = *(const u32x4*)(V + go); raw[5] = *(const u32x4*)(V + go + 8); raw[6] = *(const u32x4*)(E + go); raw[7] = *(const u32x4*)(E + go + 8);
            raw[8] = *(const u32x4*)(AL + go); raw[9] = *(const u32x4*)(AL + go + 8);
          for (int it = 0; it < NCH + 2; ++it) {
            if (it < NCH) {
                const unsigned rw[8] = {raw[0].x, raw[0].y, raw[0].z, raw[0].w, raw[1].x, raw[1].y, raw[1].z, raw[1].w}, kw[8] = {raw[2].x, raw[2].y, raw[2].z, raw[2].w, raw[3].x, raw[3].y, raw[3].z, raw[3].w};
                const unsigned vw[8] = {raw[4].x, raw[4].y, raw[4].z, raw[4].w, raw[5].x, raw[5].y, raw[5].z, raw[5].w}, ew[8] = {raw[6].x, raw[6].y, raw[6].z, raw[6].w, raw[7].x, raw[7].y, raw[7].z, raw[7].w};
                const unsigned aw[8] = {raw[8].x, raw[8].y, raw[8].z, raw[8].w, raw[9].x, raw[9].y, raw[9].z, raw[9].w};
                float rr[16], kk[16], vv[16], ww[16], lr[16], kn[16];
#pragma unroll
                for (int j = 0; j < 8; ++j) { rr[2 * j] = bf_lo(rw[j]); rr[2 * j + 1] = bf_hi(rw[j]); kk[2 * j] = bf_lo(kw[j]); kk[2 * j + 1] = bf_hi(kw[j]);
                    vv[2 * j] = bf_lo(vw[j]); vv[2 * j + 1] = bf_hi(vw[j]); ww[2 * j] = __expf(-h_lo(ew[j])); ww[2 * j + 1] = __expf(-h_hi(ew[j]));
                    lr[2 * j] = h_lo(aw[j]); lr[2 * j + 1] = h_hi(aw[j]); }
                if (it + 1 < NCH) {
                    const size_t go = gbase + (size_t)((it + 1) * TC + st) * Dm + 16 * cgp;
                    raw[0] = *(const u32x4*)(R + go); raw[1] = *(const u32x4*)(R + go + 8); raw[2] = *(const u32x4*)(Kb + go); raw[3] = *(const u32x4*)(Kb + go + 8);
                    raw[4] = *(const u32x4*)(V + go); raw[5] = *(const u32x4*)(V + go + 8); raw[6] = *(const u32x4*)(E + go); raw[7] = *(const u32x4*)(E + go + 8);
                    raw[8] = *(const u32x4*)(AL + go); raw[9] = *(const u32x4*)(AL + go + 8);
                }
                float ss = 0.f;
#pragma unroll
                for (int c = 0; c < 16; ++c) { kn[c] = kk[c] * ckk[c]; ss += kn[c] * kn[c]; }
                ss = quad_sum(ss);
                const float inv = 1.f / fmaxf(sqrtf(ss), 1e-12f);
                float bon = 0.f; float av[16], bv[16], kp[16];
#pragma unroll
                for (int c = 0; c < 16; ++c) { kn[c] *= inv; av[c] = -kn[c]; bv[c] = kn[c] * lr[c]; kp[c] = kk[c] * (1.f + (lr[c] - 1.f) * cka[c]); bon += rr[c] * kp[c] * crk[c]; }
                bon = quad_sum(bon);
                LAS float* ob = OPS + (it & 1) * (5 * TC * 64) + st * 64 + 16 * cgp;
#pragma unroll
                for (int q = 0; q < 4; ++q) {
                    *(LAS f32x4*)(ob + 0 * TC * 64 + 4 * q) = (f32x4){ww[4 * q], ww[4 * q + 1], ww[4 * q + 2], ww[4 * q + 3]};
                    *(LAS f32x4*)(ob + 1 * TC * 64 + 4 * q) = (f32x4){av[4 * q], av[4 * q + 1], av[4 * q + 2], av[4 * q + 3]};
                    *(LAS f32x4*)(ob + 2 * TC * 64 + 4 * q) = (f32x4){bv[4 * q], bv[4 * q + 1], bv[4 * q + 2], bv[4 * q + 3]};
                    *(LAS f32x4*)(ob + 3 * TC * 64 + 4 * q) = (f32x4){kp[4 * q], kp[4 * q + 1], kp[4 * q + 2], kp[4 * q + 3]};
                    *(LAS f32x4*)(ob + 4 * TC * 64 + 4 * q) = (f32x4){rr[4 * q], rr[4 * q + 1], rr[4 * q + 2], rr[4 * q + 3]};
                    *(LAS f32x4*)(VP + (it % 3) * (TC * 64) + st * 64 + 16 * cgp + 4 * q) = (f32x4){vv[4 * q], vv[4 * q + 1], vv[4 * q + 2], vv[4 * q + 3]};
                }
                if (cgp == 0) BON[(it % 3) * TC + st] = bon;
            }
            __syncthreads();
          }
        } else {
            float ckk[16], cka[16];
#pragma unroll
            for (int c = 0; c < 16; ++c) { ckk[c] = lnw[h * 64 + 16 * cgp + c]; cka[c] = lnb[h * 64 + 16 * cgp + c]; }
          for (int it = 0; it < NCH + 2; ++it) {
            if (it >= 2) {
                const int c_ = it - 2;
                const size_t go = gbase + (size_t)(c_ * TC + st) * Dm + 16 * cgp;
                const u32x4 g0 = *(const u32x4*)(G + go), g1 = *(const u32x4*)(G + go + 8);
                const LAS float* yb = YB + (c_ & 1) * (TC * 64) + st * 64 + 16 * cgp;
                const LAS float* vb = VP + (c_ % 3) * (TC * 64) + st * 64 + 16 * cgp;
                float y[16], vv[16];
#pragma unroll
                for (int q = 0; q < 4; ++q) { const f32x4 t = *(const LAS f32x4*)(yb + 4 * q), u = *(const LAS f32x4*)(vb + 4 * q);
                    y[4 * q] = t.x; y[4 * q + 1] = t.y; y[4 * q + 2] = t.z; y[4 * q + 3] = t.w; vv[4 * q] = u.x; vv[4 * q + 1] = u.y; vv[4 * q + 2] = u.z; vv[4 * q + 3] = u.w; }
                const float bon = BON[(c_ % 3) * TC + st];
                float s = 0.f;
#pragma unroll
                for (int c = 0; c < 16; ++c) s += y[c];
                const float mean = quad_sum(s) * (1.f / 64.f);
                float s2 = 0.f;
#pragma unroll
                for (int c = 0; c < 16; ++c) { y[c] -= mean; s2 += y[c] * y[c]; }
                const float rstd = rsqrtf(quad_sum(s2) * (1.f / 64.f) + LN_EPS);
                const unsigned gw_[8] = {g0.x, g0.y, g0.z, g0.w, g1.x, g1.y, g1.z, g1.w}; unsigned ow[8];
#pragma unroll
                for (int j = 0; j < 8; ++j) {
                    const float z0 = (y[2 * j] * rstd * ckk[2 * j] + cka[2 * j] + bon * vv[2 * j]) * siluf_(bf_lo(gw_[j]));
                    const float z1 = (y[2 * j + 1] * rstd * ckk[2 * j + 1] + cka[2 * j + 1] + bon * vv[2 * j + 1]) * siluf_(bf_hi(gw_[j]));
                    ow[j] = pk2(z0, z1); }
                *(u32x4*)(Z + go) = (u32x4){ow[0], ow[1], ow[2], ow[3]}; *(u32x4*)(Z + go + 8) = (u32x4){ow[4], ow[5], ow[6], ow[7]};
            }
            __syncthreads();
          }
        }
    }
}
__device__ __forceinline__ void attn_weights(int tid, const Params& p, LAS unsigned char* lds) {
    bf16_t* Wt = (bf16_t*)(p.ws + WS_W);
    TrJob jobs[2];
    jobs[0] = TrJob{p.in[20], Dm, 10240, 10240, Wt, Dm};
    jobs[1] = TrJob{p.in[23], 1024, Dm, Dm, Wt + (size_t)10240 * 2048, 1024};
    run_transposes<2>(tid, jobs, lds);
    float* COS = (float*)(p.ws + WS_COS); float* SIN = (float*)(p.ws + WS_SIN);
    const long gt = (long)blockIdx.x * NTHR + tid, GT = (long)gridDim.x * NTHR;
    for (long i = gt; i < (long)T * 16; i += GT) {
        const int t = (int)(i >> 4), f = (int)(i & 15);
        const float inv = powf(500000.0f, -(float)(2 * f) / 32.0f);
        const float ang = (float)p.positions[t] * inv; float s, c; sincosf(ang, &s, &c);
        COS[i] = c; SIN[i] = s;
    }
}
__device__ __forceinline__ void pool_weights(int tid, const Params& p, LAS unsigned char* lds) {
    bf16_t* Wt = (bf16_t*)(p.ws + WS_W);
    TrJob jobs[6];
    jobs[0] = TrJob{p.in[24], Dm, 4096, 4096, Wt, Dm};
#pragma unroll
    for (int g = 0; g < 4; ++g) jobs[1 + g] = TrJob{p.in[25] + (size_t)g * 512 * 512, 512, 512, 512, Wt + (size_t)4096 * 2048 + (size_t)g * 512 * 512, 512};
    jobs[5] = TrJob{p.in[27], Dm, Dm, Dm, Wt + (size_t)4096 * 2048 + (size_t)2048 * 512, Dm};
    run_transposes<6>(tid, jobs, lds);
}

__device__ __forceinline__ unsigned off_b(unsigned row, unsigned ch) { return 256u * row + 16u * (ch ^ (((row & 3) << 2) | ((row >> 2) & 3))); }
__device__ __forceinline__ void attn_phase(int tid, LAS unsigned char* lds, bf16_t* QKVG, float* LSE, const float* qn_w, const float* kn_w, const float* COS, const float* SIN) {
    const int w = __builtin_amdgcn_readfirstlane(tid >> 6), lane = tid & 63, fr = lane & 15, g4 = lane >> 4;
    LAS unsigned char* Kt = lds; LAS unsigned char* Vt = lds + 65536;
    const float scale = 0.08838834764831845f;
    for (int item = blockIdx.x; item < NB * 8 * 48; item += gridDim.x) {
        const int bh = item / 48, r = item % 48, b = bh >> 3, hh = bh & 7;
        int g, dil, rho, n;
        if (r < 16) { g = 0; dil = 1; rho = 0; n = r; } else if (r < 32) { g = 1; dil = 4; rho = (r - 16) >> 2; n = (r - 16) & 3; } else { g = 2; dil = 16; rho = r - 32; n = 0; }
        const int qcol = (g * 8 + hh) * 128, kcol = 3072 + qcol, vcol = 6144 + qcol;
        const size_t tok0 = (size_t)b * SEQ + rho;
        const size_t qtok = tok0 + (size_t)dil * (128 * n + 16 * w + fr);
        u32x4 qr[4]; f32x4 qw[4][2];
#pragma unroll
        for (int ks = 0; ks < 4; ++ks) { qr[ks] = *(const u32x4*)(QKVG + qtok * 10240 + qcol + 32 * ks + 8 * g4);
            qw[ks][0] = *(const f32x4*)(qn_w + g * 128 + 32 * ks + 8 * g4); qw[ks][1] = *(const f32x4*)(qn_w + g * 128 + 32 * ks + 8 * g4 + 4); }
        const f32x4 qc0 = *(const f32x4*)(COS + qtok * 16 + (g4 & 1) * 8), qc1 = *(const f32x4*)(COS + qtok * 16 + (g4 & 1) * 8 + 4), qs0 = *(const f32x4*)(SIN + qtok * 16 + (g4 & 1) * 8), qs1 = *(const f32x4*)(SIN + qtok * 16 + (g4 & 1) * 8 + 4);
        __syncthreads();
        {
            const int ch = tid & 15; const float sgk = (ch < 2) ? -1.f : 1.f;
            const f32x4 kw0 = *(const f32x4*)(kn_w + g * 128 + ch * 8), kw1 = *(const f32x4*)(kn_w + g * 128 + ch * 8 + 4);
            const float kwv[8] = {kw0.x, kw0.y, kw0.z, kw0.w, kw1.x, kw1.y, kw1.z, kw1.w};
#pragma unroll
            for (int ih = 0; ih < 2; ++ih) {
                if (ih == 0 && n == 0) {
#pragma unroll
                    for (int i2 = 0; i2 < 4; ++i2) { const int row = (tid >> 4) + 32 * i2; *(LAS u32x4*)(Kt + off_b(row, ch)) = (u32x4){0u, 0u, 0u, 0u}; *(LAS u32x4*)(Vt + off_b(row, ch)) = (u32x4){0u, 0u, 0u, 0u}; }
                    continue;
                }
                u32x4 kv[4], vv[4]; f32x4 cs[4][4];
#pragma unroll
                for (int i2 = 0; i2 < 4; ++i2) {
                    const int row = (tid >> 4) + 32 * (4 * ih + i2), s = 128 * (n - 1) + row;
                    kv[i2] = (u32x4){0u, 0u, 0u, 0u}; vv[i2] = kv[i2];
#pragma unroll
                    for (int q = 0; q < 4; ++q) cs[i2][q] = (f32x4){0.f, 0.f, 0.f, 0.f};
                    if (s >= 0) { const size_t tk = tok0 + (size_t)dil * s; const bf16_t* src = QKVG + tk * 10240 + ch * 8; kv[i2] = *(const u32x4*)(src + kcol); vv[i2] = *(const u32x4*)(src + vcol);
                        if (ch < 4) { const float* cp = COS + tk * 16 + (ch & 1) * 8; const float* sp = SIN + tk * 16 + (ch & 1) * 8;
                            cs[i2][0] = *(const f32x4*)cp; cs[i2][1] = *(const f32x4*)(cp + 4); cs[i2][2] = *(const f32x4*)sp; cs[i2][3] = *(const f32x4*)(sp + 4); } }
                }
#pragma unroll
                for (int i2 = 0; i2 < 4; ++i2) {
                    const int row = (tid >> 4) + 32 * (4 * ih + i2);
                    const unsigned rw[4] = {kv[i2].x, kv[i2].y, kv[i2].z, kv[i2].w};
                    float x[8]; float ss = 0.f;
#pragma unroll
                    for (int j = 0; j < 4; ++j) { x[2 * j] = bf_lo(rw[j]); x[2 * j + 1] = bf_hi(rw[j]); ss += x[2 * j] * x[2 * j] + x[2 * j + 1] * x[2 * j + 1]; }
                    const float rstd = rsqrtf(row16_sum(ss) * (1.f / 128.f) + RMS_EPS);
                    const float cv[8] = {cs[i2][0].x, cs[i2][0].y, cs[i2][0].z, cs[i2][0].w, cs[i2][1].x, cs[i2][1].y, cs[i2][1].z, cs[i2][1].w};
                    const float sv[8] = {cs[i2][2].x, cs[i2][2].y, cs[i2][2].z, cs[i2][2].w, cs[i2][3].x, cs[i2][3].y, cs[i2][3].z, cs[i2][3].w};
#pragma unroll
                    for (int j = 0; j < 8; ++j) { x[j] = x[j] * rstd * kwv[j];
                        const float px = __int_as_float(__builtin_amdgcn_update_dpp(0, __float_as_int(x[j]), 0x4E, 0xF, 0xF, true));
                        x[j] = (ch < 4) ? x[j] * cv[j] + sgk * px * sv[j] : x[j]; }
                    u32x4 ko; ko.x = pk2(x[0], x[1]); ko.y = pk2(x[2], x[3]); ko.z = pk2(x[4], x[5]); ko.w = pk2(x[6], x[7]);
                    *(LAS u32x4*)(Kt + off_b(row, ch)) = ko; *(LAS u32x4*)(Vt + off_b(row, ch)) = vv[i2];
                }
            }
        }
        bf16x8 qf[4];
        {
            const f32x4 c0 = qc0, c1 = qc1, s0 = qs0, s1 = qs1;
            float x[4][8]; float ss = 0.f;
#pragma unroll
            for (int ks = 0; ks < 4; ++ks) { const unsigned rw[4] = {qr[ks].x, qr[ks].y, qr[ks].z, qr[ks].w};
#pragma unroll
                for (int j = 0; j < 4; ++j) { x[ks][2 * j] = bf_lo(rw[j]); x[ks][2 * j + 1] = bf_hi(rw[j]); ss += x[ks][2 * j] * x[ks][2 * j] + x[ks][2 * j + 1] * x[ks][2 * j + 1]; } }
            ss += __shfl_xor(ss, 16); ss += __shfl_xor(ss, 32);
            const float rstd = rsqrtf(ss * (1.f / 128.f) + RMS_EPS);
#pragma unroll
            for (int ks = 0; ks < 4; ++ks)
#pragma unroll
                for (int j = 0; j < 8; ++j) x[ks][j] = x[ks][j] * rstd * qw[ks][j >> 2][j & 3];
            const float cv[8] = {c0.x, c0.y, c0.z, c0.w, c1.x, c1.y, c1.z, c1.w}, sv[8] = {s0.x, s0.y, s0.z, s0.w, s1.x, s1.y, s1.z, s1.w};
            const float sgq = (g4 < 2) ? -1.f : 1.f;
#pragma unroll
            for (int j = 0; j < 8; ++j) { const float px = __shfl_xor(x[0][j], 32); x[0][j] = x[0][j] * cv[j] + sgq * px * sv[j]; }
#pragma unroll
            for (int ks = 0; ks < 4; ++ks) { u32x4 t; t.x = pk2(x[ks][0], x[ks][1]); t.y = pk2(x[ks][2], x[ks][3]); t.z = pk2(x[ks][4], x[ks][5]); t.w = pk2(x[ks][6], x[ks][7]); qf[ks] = __builtin_bit_cast(bf16x8, t); }
        }
        __syncthreads();
        f32x4 sacc[9];
#pragma unroll
        for (int kbi = 0; kbi < 9; ++kbi) { sacc[kbi] = (f32x4){0.f, 0.f, 0.f, 0.f};
#pragma unroll
            for (int ks = 0; ks < 4; ++ks) { const bf16x8 kf = *(const LAS bf16x8*)(Kt + off_b(16 * (w + kbi) + fr, 4 * ks + g4));
                sacc[kbi] = __builtin_amdgcn_mfma_f32_16x16x32_bf16(kf, qf[ks], sacc[kbi], 0, 0, 0); } }
        const int qi = 16 * w + fr;
        float mx = -3.0e38f;
#pragma unroll
        for (int kbi = 0; kbi < 9; ++kbi)
#pragma unroll
            for (int j = 0; j < 4; ++j) { const int kj = 16 * (w + kbi) + 4 * g4 + j; const bool ok = (kj >= qi) && (kj <= qi + 128) && (n > 0 || kj >= 128);
                const float sv = ok ? sacc[kbi][j] * scale : -3.0e38f; sacc[kbi][j] = sv; mx = fmaxf(mx, sv); }
        mx = fmaxf(mx, __shfl_xor(mx, 16)); mx = fmaxf(mx, __shfl_xor(mx, 32));
        float l = 0.f;
#pragma unroll
        for (int kbi = 0; kbi < 9; ++kbi)
#pragma unroll
            for (int j = 0; j < 4; ++j) { const float pv = (sacc[kbi][j] > -1.0e38f) ? __expf(sacc[kbi][j] - mx) : 0.f; sacc[kbi][j] = pv; l += pv; }
        l += __shfl_xor(l, 16); l += __shfl_xor(l, 32);
        if (g4 == 0) LSE[((size_t)g * T + qtok) * 8 + hh] = mx + __logf(l);
        bf16x8 pb[5];
#pragma unroll
        for (int s5 = 0; s5 < 5; ++s5) { u32x4 t;
            t.x = pk2(sacc[2 * s5][0], sacc[2 * s5][1]); t.y = pk2(sacc[2 * s5][2], sacc[2 * s5][3]);
            if (s5 < 4) { t.z = pk2(sacc[2 * s5 + 1][0], sacc[2 * s5 + 1][1]); t.w = pk2(sacc[2 * s5 + 1][2], sacc[2 * s5 + 1][3]); } else { t.z = 0u; t.w = 0u; }
            pb[s5] = __builtin_bit_cast(bf16x8, t); }
        const float rl = 1.f / l;
        const unsigned q_ = fr >> 2, p_ = fr & 3;
        bf16_t* orow = QKVG + qtok * 10240 + qcol + 4 * g4;
#pragma unroll
        for (int c = 0; c < 8; ++c) {
            const unsigned vbase = (unsigned)(size_t)Vt + 256u * (16u * w + 4u * g4 + q_) + 16u * ((2u * c + (p_ >> 1)) ^ ((q_ << 2) | (unsigned)g4)) + 8u * (p_ & 1);
            u32x2 t0, t1, t2, t3, t4, t5, t6, t7, t8;
            asm volatile("ds_read_b64_tr_b16 %0, %9 offset:0\n\tds_read_b64_tr_b16 %1, %9 offset:4096\n\tds_read_b64_tr_b16 %2, %9 offset:8192\n\t"
                         "ds_read_b64_tr_b16 %3, %9 offset:12288\n\tds_read_b64_tr_b16 %4, %9 offset:16384\n\tds_read_b64_tr_b16 %5, %9 offset:20480\n\t"
                         "ds_read_b64_tr_b16 %6, %9 offset:24576\n\tds_read_b64_tr_b16 %7, %9 offset:28672\n\tds_read_b64_tr_b16 %8, %9 offset:32768\n\t"
                         "s_waitcnt lgkmcnt(0)"
                         : "=&v"(t0), "=&v"(t1), "=&v"(t2), "=&v"(t3), "=&v"(t4), "=&v"(t5), "=&v"(t6), "=&v"(t7), "=&v"(t8) : "v"(vbase) : "memory");
            f32x4 oacc = (f32x4){0.f, 0.f, 0.f, 0.f};
            oacc = __builtin_amdgcn_mfma_f32_16x16x32_bf16(__builtin_bit_cast(bf16x8, (u32x4){t0.x, t0.y, t1.x, t1.y}), pb[0], oacc, 0, 0, 0);
            oacc = __builtin_amdgcn_mfma_f32_16x16x32_bf16(__builtin_bit_cast(bf16x8, (u32x4){t2.x, t2.y, t3.x, t3.y}), pb[1], oacc, 0, 0, 0);
            oacc = __builtin_amdgcn_mfma_f32_16x16x32_bf16(__builtin_bit_cast(bf16x8, (u32x4){t4.x, t4.y, t5.x, t5.y}), pb[2], oacc, 0, 0, 0);
            oacc = __builtin_amdgcn_mfma_f32_16x16x32_bf16(__builtin_bit_cast(bf16x8, (u32x4){t6.x, t6.y, t7.x, t7.y}), pb[3], oacc, 0, 0, 0);
            oacc = __builtin_amdgcn_mfma_f32_16x16x32_bf16(__builtin_bit_cast(bf16x8, (u32x4){t8.x, t8.y, t8.x, t8.y}), pb[4], oacc, 0, 0, 0);
            u32x2 o; o.x = pk2(oacc[0] * rl, oacc[1] * rl); o.y = pk2(oacc[2] * rl, oacc[3] * rl);
            *(u32x2*)(orow + 16 * c) = o;
        }
    }
}
__device__ __forceinline__ void attn_combine_phase(int tid, const bf16_t* QKVG, const float* LSE, bf16_t* Z) {
    const long gt = (long)blockIdx.x * NTHR + tid, GT = (long)gridDim.x * NTHR;
    for (long i = gt; i < (long)T * 128; i += GT) {
        const size_t t = (size_t)(i >> 7); const int hh = (int)((i >> 4) & 7), d8 = (int)(i & 15);
        const float l0 = LSE[((size_t)0 * T + t) * 8 + hh], l1 = LSE[((size_t)1 * T + t) * 8 + hh], l2 = LSE[((size_t)2 * T + t) * 8 + hh];
        const float mx = fmaxf(l0, fmaxf(l1, l2)); float w0 = __expf(l0 - mx), w1 = __expf(l1 - mx), w2 = __expf(l2 - mx); const float rs = 1.f / (w0 + w1 + w2); w0 *= rs; w1 *= rs; w2 *= rs;
        const bf16_t* row = QKVG + t * 10240 + hh * 128 + d8 * 8;
        const u32x4 o0 = *(const u32x4*)row, o1 = *(const u32x4*)(row + 1024), o2 = *(const u32x4*)(row + 2048), gg = *(const u32x4*)(row + 9216);
        const unsigned a0[4] = {o0.x, o0.y, o0.z, o0.w}, a1[4] = {o1.x, o1.y, o1.z, o1.w}, a2[4] = {o2.x, o2.y, o2.z, o2.w}, ga[4] = {gg.x, gg.y, gg.z, gg.w}; unsigned ow[4];
#pragma unroll
        for (int j = 0; j < 4; ++j) {
            const float lo = (w0 * bf_lo(a0[j]) + w1 * bf_lo(a1[j]) + w2 * bf_lo(a2[j])) * siluf_(bf_lo(ga[j]));
            const float hi = (w0 * bf_hi(a0[j]) + w1 * bf_hi(a1[j]) + w2 * bf_hi(a2[j])) * siluf_(bf_hi(ga[j]));
            ow[j] = pk2(lo, hi); }
        *(u32x4*)(Z + t * 1024 + hh * 128 + d8 * 8) = (u32x4){ow[0], ow[1], ow[2], ow[3]};
    }
}
__device__ __forceinline__ void pool_diff_phase(int tid, const bf16_t* UG, bf16_t* DIFF) {
    const long gt = (long)blockIdx.x * NTHR + tid, GT = (long)gridDim.x * NTHR;
    for (long i = gt; i < (long)NB * 32 * 256; i += GT) {
        const int c8 = (int)(i & 255), chunk = (int)((i >> 8) & 31), b = (int)(i >> 13);
        const int win = 2 << (c8 >> 6); const float rwin = 1.f / (float)win;
        const int t0 = chunk * 64;
        const bf16_t* ub = UG + (size_t)b * SEQ * 4096 + c8 * 8;
        float sum[8];
#pragma unroll
        for (int j = 0; j < 8; ++j) sum[j] = 0.f;
        for (int s = t0 - win + 1; s < t0; ++s) if (s >= 0) { const u32x4 v = *(const u32x4*)(ub + (size_t)s * 4096); const unsigned vw[4] = {v.x, v.y, v.z, v.w};
#pragma unroll
            for (int j = 0; j < 4; ++j) { sum[2 * j] += bf_lo(vw[j]); sum[2 * j + 1] += bf_hi(vw[j]); } }
        for (int t = t0; t < t0 + 64; ++t) {
            const u32x4 v = *(const u32x4*)(ub + (size_t)t * 4096); const unsigned vw[4] = {v.x, v.y, v.z, v.w};
            float u[8];
#pragma unroll
            for (int j = 0; j < 4; ++j) { u[2 * j] = bf_lo(vw[j]); u[2 * j + 1] = bf_hi(vw[j]); sum[2 * j] += u[2 * j]; sum[2 * j + 1] += u[2 * j + 1]; }
            const float rc = (t + 1 < win) ? 1.f / (float)(t + 1) : rwin;
            u32x4 o; o.x = pk2(sum[0] * rc - u[0], sum[1] * rc - u[1]); o.y = pk2(sum[2] * rc - u[2], sum[3] * rc - u[3]);
            o.z = pk2(sum[4] * rc - u[4], sum[5] * rc - u[5]); o.w = pk2(sum[6] * rc - u[6], sum[7] * rc - u[7]);
            *(u32x4*)(DIFF + ((size_t)b * SEQ + t) * Dm + c8 * 8) = o;
            if (t - win + 1 >= 0) { const u32x4 q = *(const u32x4*)(ub + (size_t)(t - win + 1) * 4096); const unsigned qw[4] = {q.x, q.y, q.z, q.w};
#pragma unroll
                for (int j = 0; j < 4; ++j) { sum[2 * j] -= bf_lo(qw[j]); sum[2 * j + 1] -= bf_hi(qw[j]); } }
        }
    }
}

#define XB_TMO      128
#define XB_XCNT(j)  (256  + 64 * (j))
#define XB_XSUB(j)  (1280 + 64 * (j))
#define XB_XGEN(j)  (2304 + 64 * (j))
#define XB_TOP      3328
#define XB_TOPGEN   3392
#define XCD_BAR_WORDS 3456
#define XB_SPIN_CAP (1u << 20)
__device__ __forceinline__ unsigned xb_ld(unsigned* p)              { return __hip_atomic_load(p, __ATOMIC_RELAXED, __HIP_MEMORY_SCOPE_AGENT); }
__device__ __forceinline__ unsigned xb_add(unsigned* p, unsigned v) { return __hip_atomic_fetch_add(p, v, __ATOMIC_RELAXED, __HIP_MEMORY_SCOPE_AGENT); }
__device__ __forceinline__ unsigned xb_xcc_id() { return (unsigned)__builtin_amdgcn_s_getreg((3 << 11) | 20) & 0xFu; }
#define XB_SPIN(cond, bar) do { unsigned _sp = 0; while (cond) { __builtin_amdgcn_s_sleep(1); \
    if ((++_sp & 255u) == 0u) { if (xb_ld(&(bar)[XB_TMO])) break; if (_sp > XB_SPIN_CAP) { atomicAdd(&(bar)[XB_TMO], 1u); break; } } } } while (0)
struct XcdBarrier { unsigned* bar; unsigned x; volatile LAS unsigned* st; };
__device__ __forceinline__ XcdBarrier xcd_barrier_post(unsigned* bar, volatile LAS unsigned* st) {
    XcdBarrier b; b.bar = bar; b.x = xb_xcc_id(); b.st = st;
    if (threadIdx.x == 0) (void)xb_add(&bar[XB_XCNT(b.x)], 1u);
    return b;
}
__device__ __forceinline__ void xcd_barrier_complete(unsigned* bar, unsigned x, unsigned& nloc, unsigned& nx) {
    const unsigned G = gridDim.x * gridDim.y * gridDim.z;
    unsigned sum, cnt, mine, sp = 0u;
    for (;;) {
        sum = 0u; cnt = 0u; mine = 0u;
#pragma unroll
        for (unsigned j = 0; j < 16; ++j) { const unsigned c = xb_ld(&bar[XB_XCNT(j)]); sum += c; cnt += (c > 0u) ? 1u : 0u; mine = (j == x) ? c : mine; }
        if (sum == G) break;
        __builtin_amdgcn_s_sleep(1);
        if ((++sp & 255u) == 0u) { if (xb_ld(&bar[XB_TMO])) break; if (sp > XB_SPIN_CAP) { atomicAdd(&bar[XB_TMO], 1u); break; } }
    }
    nloc = mine > 0u ? mine : 1u; nx = cnt > 0u ? cnt : 1u;
}
__device__ __forceinline__ void xcd_barrier(const XcdBarrier& b) {
    asm volatile("s_waitcnt vmcnt(0)" ::: "memory");
    __syncthreads();
    if (threadIdx.x == 0) {
        unsigned* bar = b.bar;
        __builtin_amdgcn_s_waitcnt(0);
        unsigned nloc = b.st[0], nx = b.st[1];
        if (nloc == 0u) { xcd_barrier_complete(bar, b.x, nloc, nx); b.st[0] = nloc; b.st[1] = nx; }
        const unsigned old = xb_add(&bar[XB_XSUB(b.x)], 1u);
        const unsigned gen = old / nloc;
        if (old + 1u == (gen + 1u) * nloc) {
            __builtin_amdgcn_fence(__ATOMIC_RELEASE, "agent");
            asm volatile("s_waitcnt vmcnt(0)" ::: "memory");
            const unsigned og = xb_add(&bar[XB_TOP], 1u);
            const unsigned tg = og / nx;
            if (og + 1u == (tg + 1u) * nx) xb_add(&bar[XB_TOPGEN], 1u);
            else XB_SPIN(xb_ld(&bar[XB_TOPGEN]) == tg, bar);
            __builtin_amdgcn_fence(__ATOMIC_ACQUIRE, "agent");
            xb_add(&bar[XB_XGEN(b.x)], 1u);
            asm volatile("s_waitcnt vmcnt(0)" ::: "memory");
        } else {
            XB_SPIN(xb_ld(&bar[XB_XGEN(b.x)]) == gen, bar);
            __builtin_amdgcn_fence(__ATOMIC_ACQUIRE, "agent");
            asm volatile("s_waitcnt vmcnt(0)" ::: "memory");
        }
    }
    __syncthreads();
}

__global__ void __launch_bounds__(NTHR) mega_fwd(Params p) {
    extern __shared__ __attribute__((aligned(16))) unsigned char lds_raw[];
    LAS unsigned char* lds = (LAS unsigned char*)lds_raw;
    cg::grid_group grid = cg::this_grid();
    const int ph_lo = p.ph_lo, ph_hi = p.ph_hi;
    volatile LAS unsigned* xst = (volatile LAS unsigned*)(lds + LDS_BYTES);
    if (threadIdx.x == 0) { xst[0] = 0u; xst[1] = 0u; }
    __syncthreads();
    const XcdBarrier xb = xcd_barrier_post((unsigned*)(p.ws + WS_BAR), xst);
    bool first_sync = true;
    int ph = 0;
#define RUN(ty, ...) do { if (ph >= ph_lo && ph < ph_hi) { { int tid = threadIdx.x; asm volatile("" : "+v"(tid)); __VA_ARGS__; } \
        if (ph + 1 < ph_hi) { if (first_sync) { grid.sync(); first_sync = false; } else xcd_barrier(xb); } } ++ph; } while (0)
    unsigned char* ws = p.ws;
    bf16_t* Wt = (bf16_t*)(ws + WS_W);
    bf16_t* LORA = (bf16_t*)(ws + WS_LORA);
    bf16_t* VF = (bf16_t*)(ws + WS_VF); bf16_t* B1 = (bf16_t*)(ws + WS_B1); bf16_t* B2 = (bf16_t*)(ws + WS_B2); bf16_t* B3 = (bf16_t*)(ws + WS_B3);
    bf16_t* B4 = (bf16_t*)(ws + WS_B4); bf16_t* M0 = (bf16_t*)(ws + WS_M0); bf16_t* M1 = (bf16_t*)(ws + WS_M1);
    for (int L = 0; L < 4; ++L) {
        const int kind = L % 3;
        bf16_t* XSA = (bf16_t*)p.out; bf16_t* XSB = XSA + (size_t)T * Dm;
        const void* xin = (L == 0) ? (const void*)p.in[0] : (L == 2) ? (const void*)XSB : (const void*)XSA;
        const float* nw = p.in[2] + (size_t)L * Dm;
        const bf16_t* oA; const bf16_t* oB; int olda, ont;
        if (kind == 0) {
            const int ia = L / 3; const bool has_v = ia > 0;
            const float* mu = p.in[3] + (size_t)ia * 6 * Dm;
            bf16_t* Vb = has_v ? B3 : VF;
            for (int rd = 0; rd < 2; ++rd) {
                RUN(0, if (rd == 0) rwkv_weights(tid, p, ia, has_v, lds);
                    if (L == 0) norm_mix_phase<3, false>(tid, xin, nw, mu + (size_t)(3 * rd) * Dm, mu + (size_t)(3 * rd + 1) * Dm, M0, M1, mu + (size_t)(3 * rd + 2) * Dm, XSB);
                    else norm_mix_phase<3, true>(tid, xin, nw, mu + (size_t)(3 * rd) * Dm, mu + (size_t)(3 * rd + 1) * Dm, M0, M1, mu + (size_t)(3 * rd + 2) * Dm, XSB));
                RUN(1, ProbRwkvIn pr; pr.nM = T / BM; pr.nN = (rd == 0) ? (has_v ? 25 : 24) : 10; pr.nt = Dm / BK; pr.lda = Dm; pr.ldb = Dm; pr.round = rd;
                    pr.A0 = M0; pr.dA1 = M1 - M0; pr.dA2 = (long)(((const char*)XSB - (const char*)M0) / 2); pr.Wt = Wt;
                    pr.O0 = B1; pr.dO1 = B2 - B1; pr.dO2 = Vb - B1; pr.dO3 = B4 - B1; pr.lora = LORA; gemm_phase(tid, lds, pr));
            }
            RUN(2, ProbRwkvUp pu; pu.nM = T / BM; pu.nN = has_v ? 24 : 16; pu.nt = 4; pu.lda = 256; pu.ldb = 256; pu.A = LORA; pu.Bt = Wt + (size_t)11008 * 2048;
                pu.w0 = p.in[5] + (size_t)ia * Dm; pu.d_a0 = (long)((p.in[8] + (size_t)ia * Dm) - pu.w0); pu.d_v0 = (long)(p.in[16] - pu.w0); pu.E = M0; pu.AL = M1; pu.V = B3; pu.VF = VF; gemm_phase(tid, lds, pu));
            RUN(3, scan_phase(tid, lds, B1, M0, B2, Vb, M1, B4, p.in[11] + (size_t)ia * Dm, p.in[12] + (size_t)ia * Dm, p.in[13] + (size_t)ia * Dm, p.in[14] + (size_t)ia * Dm, p.in[15] + (size_t)ia * Dm, B1));
            if (has_v) { RUN(9, { const u32x4* src = (const u32x4*)XSA; u32x4* dst = (u32x4*)B2; const long n16 = (long)T * Dm / 8;
                for (long i = (long)blockIdx.x * NTHR + tid; i < n16; i += (long)gridDim.x * NTHR) dst[i] = src[i]; }); }
            oA = B1; oB = Wt + (size_t)8192 * 2048; olda = Dm; ont = Dm / BK;
        } else {
            RUN(4, if (kind == 1) attn_weights(tid, p, lds); else pool_weights(tid, p, lds); norm_mix_phase<0, true>(tid, xin, nw, nullptr, nullptr, M1, nullptr));
            RUN(5, ProbStoreBf16 ps; ps.nM = T / BM; ps.nN = (kind == 1) ? 40 : 16; ps.nt = Dm / BK; ps.lda = Dm; ps.ldb = Dm; ps.A = M1; ps.Bt = Wt; ps.O = B1; ps.ldo = (kind == 1) ? 10240 : 4096; gemm_phase(tid, lds, ps));
            if (kind == 1) {
                RUN(7, attn_phase(tid, lds, B1, (float*)(ws + WS_LSE), p.in[21], p.in[22], (const float*)(ws + WS_COS), (const float*)(ws + WS_SIN)));
                RUN(8, attn_combine_phase(tid, B1, (const float*)(ws + WS_LSE), M1));
                oA = M1; oB = Wt + (size_t)10240 * 2048; olda = 1024; ont = 1024 / BK;
            } else {
                RUN(9, pool_diff_phase(tid, B1, B3));
                RUN(10, ProbPoolGrp pg; pg.nM = T / BM; pg.nN = 8; pg.nt = 512 / BK; pg.lda = Dm; pg.ldb = 512; pg.A = B3; pg.Bt = Wt + (size_t)4096 * 2048; pg.scale = p.in[26]; pg.UG = B1; pg.Z = B4; gemm_phase(tid, lds, pg));
                oA = B4; oB = Wt + (size_t)4096 * 2048 + (size_t)2048 * 512; olda = Dm; ont = Dm / BK;
            }
        }
        RUN(11, ProbResid po; po.nM = T / BM; po.nN = 8; po.nt = ont; po.lda = olda; po.ldb = olda; po.A = oA; po.Bt = oB; po.xin = (L == 3) ? (const void*)B2 : xin; po.in_bf = (L != 0); po.xout = (L == 0) ? (void*)XSA : (L == 1) ? (void*)XSB : (L == 2) ? (void*)XSA : (void*)p.out; po.out_bf = (L != 3); gemm_phase(tid, lds, po));
    }
#undef RUN
}
constexpr int N_PHASES = 7 + 5 + 5 + 8;

extern "C" void kernel_launch(void* const* d_in, const int* in_sizes, int n_in, void* d_out, int out_size, void* d_ws, size_t ws_size, hipStream_t stream) {
    static int grid = 0;
    if (grid == 0) {
        if (n_in != 28 || ws_size < WS_END) { fprintf(stderr, "kernel_launch: unexpected n_in %d / ws_size %zu\n", n_in, ws_size); grid = -1; return; }
        int dev = 0, cus = 0, per_cu = 0;
        hipGetDevice(&dev); hipDeviceGetAttribute(&cus, hipDeviceAttributeMultiprocessorCount, dev);
        if (hipFuncSetAttribute((const void*)mega_fwd, hipFuncAttributeMaxDynamicSharedMemorySize, LDS_BYTES + 64) != hipSuccess) { fprintf(stderr, "kernel_launch: hipFuncSetAttribute failed\n"); grid = -1; return; }
        if (hipOccupancyMaxActiveBlocksPerMultiprocessor(&per_cu, (const void*)mega_fwd, NTHR, LDS_BYTES + 64) != hipSuccess || per_cu < 1) { fprintf(stderr, "kernel_launch: occupancy query failed (%d)\n", per_cu); per_cu = 1; }
        (void)hipGetLastError();
        grid = cus;
    }
    if (grid < 0) return;
    if (hipMemsetAsync((unsigned char*)d_ws + WS_BAR, 0, XCD_BAR_WORDS * 4, stream) != hipSuccess) { fprintf(stderr, "kernel_launch: memset failed\n"); return; }
    Params p{};
    for (int i = 0; i < 28; ++i) p.in[i] = (const float*)d_in[i];
    p.positions = (const int*)d_in[1]; p.out = (float*)d_out; p.ws = (unsigned char*)d_ws;
#if MK_MULTI
    for (int k = 0; k < N_PHASES; ++k) { p.ph_lo = k; p.ph_hi = k + 1; hipLaunchKernelGGL(mega_fwd, dim3(grid), dim3(NTHR), LDS_BYTES + 64, stream, p); }
#else
    p.ph_lo = 0; p.ph_hi = N_PHASES;
    void* args[] = {&p};
    hipError_t e = hipLaunchCooperativeKernel((const void*)mega_fwd, dim3(grid), dim3(NTHR), args, LDS_BYTES + 64, stream);
    if (e != hipSuccess) fprintf(stderr, "cooperative launch failed: %s (grid %d)\n", hipGetErrorString(e), grid);
#endif
}
```

```cpp
#include <hip/hip_runtime.h>
#include <hip/hip_cooperative_groups.h>
#include <cstdio>
namespace cg = cooperative_groups;

#ifndef MK_MULTI
#define MK_MULTI 0
#endif

#define LAS __attribute__((address_space(3)))
typedef unsigned short bf16_t;
typedef short bf16x8 __attribute__((ext_vector_type(8)));
typedef float f32x4 __attribute__((ext_vector_type(4)));
typedef float f32x2 __attribute__((ext_vector_type(2)));
typedef unsigned u32x4 __attribute__((ext_vector_type(4)));
typedef unsigned u32x2 __attribute__((ext_vector_type(2)));
typedef unsigned short u16x4 __attribute__((ext_vector_type(4)));

constexpr int Dm = 2048, NB = 16, SEQ = 2048, T = NB * SEQ;
constexpr float RMS_EPS = 1e-6f, LN_EPS = 64e-5f;
constexpr int NTHR = 512, NWAVE = 8;
constexpr int LDS_BYTES = 128 * 1024;
constexpr size_t MiB = 1024 * 1024;
constexpr size_t WS_W = 0;
constexpr size_t WS_LORA = 64 * MiB;
constexpr size_t WS_COS = 80 * MiB;
constexpr size_t WS_SIN = 82 * MiB;
constexpr size_t WS_LSE = 84 * MiB;
constexpr size_t WS_BAR = 88 * MiB;
constexpr size_t WS_VF = 128 * MiB;
constexpr size_t WS_B1 = 256 * MiB, WS_B2 = 384 * MiB, WS_B3 = 512 * MiB, WS_B4 = 640 * MiB, WS_M0 = 768 * MiB, WS_M1 = 896 * MiB;
constexpr size_t WS_END = 1024 * MiB;

struct Params {
    const float* in[28];
    const int* positions;
    float* out;
    unsigned char* ws;
    int ph_lo, ph_hi;
};

__device__ __forceinline__ unsigned pk2(float lo, float hi) { unsigned r; asm volatile("v_cvt_pk_bf16_f32 %0, %1, %2" : "=v"(r) : "v"(lo), "v"(hi)); return r; }
__device__ __forceinline__ float bf_lo(unsigned u) { return __uint_as_float(u << 16); }
__device__ __forceinline__ float bf_hi(unsigned u) { return __uint_as_float(u & 0xffff0000u); }
__device__ __forceinline__ unsigned pkh2(float lo, float hi) { typedef _Float16 h2 __attribute__((ext_vector_type(2))); h2 v; v.x = (_Float16)lo; v.y = (_Float16)hi; return __builtin_bit_cast(unsigned, v); }
__device__ __forceinline__ float h_lo(unsigned u) { typedef _Float16 h2 __attribute__((ext_vector_type(2))); h2 v = __builtin_bit_cast(h2, u); return (float)v.x; }
__device__ __forceinline__ float h_hi(unsigned u) { typedef _Float16 h2 __attribute__((ext_vector_type(2))); h2 v = __builtin_bit_cast(h2, u); return (float)v.y; }
__device__ __forceinline__ float wave_sum(float v) {
#pragma unroll
    for (int o = 1; o < 64; o <<= 1) v += __shfl_xor(v, o);
    return v;
}
__device__ __forceinline__ float quad_sum(float v) {
    v += __int_as_float(__builtin_amdgcn_update_dpp(0, __float_as_int(v), 0xB1, 0xF, 0xF, true));
    v += __int_as_float(__builtin_amdgcn_update_dpp(0, __float_as_int(v), 0x4E, 0xF, 0xF, true));
    return v;
}
__device__ __forceinline__ float row16_sum(float v) {
    v = quad_sum(v);
    v += __int_as_float(__builtin_amdgcn_update_dpp(0, __float_as_int(v), 0x124, 0xF, 0xF, true));
    v += __int_as_float(__builtin_amdgcn_update_dpp(0, __float_as_int(v), 0x128, 0xF, 0xF, true));
    return v;
}
__device__ __forceinline__ float sigmoidf_(float x) { return 1.f / (1.f + __expf(-x)); }
__device__ __forceinline__ float siluf_(float x) { return x / (1.f + __expf(-x)); }

constexpr int BM = 256, BK = 64, HALF = 128, HTB = HALF * BK * 2, NXCD = 8, WGM = 8;
__device__ __forceinline__ int lds_byte(int r, int c) { const int st = (r >> 4) * 2 + (c >> 5), rr = r & 15, cc = c & 31, ob = rr * 64 + cc * 2; return st * 1024 + (ob ^ (((ob >> 9) & 1) << 5)); }
__device__ __forceinline__ void stage_rc(int b, int& R, int& C) { const int st = b / 1024, sb = b % 1024, swz = sb ^ (((sb >> 9) & 1) << 5); R = (st >> 1) * 16 + swz / 64; C = (st & 1) * 32 + (swz % 64) / 2; }
__device__ __forceinline__ int perm32(int rho) { const int n = rho >> 4, i = rho & 15; return 8 * (i >> 2) + 4 * n + (i & 3); }
struct Unit { int pm, pn; };
__device__ __forceinline__ bool unit_next(int nM, int nN, int i, Unit& u) {
    const int nwg = nM * nN; const long L = (long)i * gridDim.x + blockIdx.x; if (L >= nwg) return false;
    int wgid = (int)L; { const int q = nwg / NXCD, r = nwg % NXCD, xcd = wgid % NXCD, off = wgid / NXCD; wgid = (xcd < r ? xcd * (q + 1) : r * (q + 1) + (xcd - r) * q) + off; }
    const int nig = WGM * nN, gid = wgid / nig, fm = gid * WGM, gsz = (nM - fm) < WGM ? (nM - fm) : WGM;
    u.pm = fm + ((wgid % nig) % gsz); u.pn = (wgid % nig) / gsz; return true;
}

template <class P>
__device__ __forceinline__ void gemm_phase(int tid, LAS unsigned char* lds, const P& prob) {
    const int wid = __builtin_amdgcn_readfirstlane(tid >> 6), lane = tid & 63, wr = wid >> 2, wc = wid & 3, fr = lane & 15, fq = lane >> 4;
    const int nt = prob.nt;
    unsigned voffA[2], voffB[2];
#pragma unroll
    for (int i = 0; i < 2; ++i) { int R, C; stage_rc(tid * 16 + i * 8192, R, C); const int Rb = P::PERM ? ((R & ~31) + perm32(R & 31)) : R;
        voffA[i] = (unsigned)(R * prob.lda + C) * 2u; voffB[i] = (unsigned)(Rb * prob.ldb + C) * 2u; }
    const size_t kstep = (size_t)(BK * 2);
    const size_t hstepA = (size_t)HALF * prob.lda * 2, hstepB = (size_t)HALF * prob.ldb * 2;
    const unsigned ldsw = (unsigned)wid * 1024u;
    const int aoff = lds_byte(wr * 64 + fr, fq * 8), boff = lds_byte(wc * 32 + fr, fq * 8);
#define G_SA(b, h) (((b) * 2 + (h)) * HTB)
#define G_SB(b, h) ((4 + (b) * 2 + (h)) * HTB)
#define G_STAGE(bufoff, gbase, voff) do { _Pragma("unroll") for (int _i = 0; _i < 2; ++_i) \
        __builtin_amdgcn_global_load_lds((const unsigned*)((const char*)(gbase) + (voff)[_i]), (LAS unsigned*)(lds + (bufoff) + ldsw + _i * 8192), 16, 0, 0); } while (0)
#define G_LDA(dst, b, h) do { _Pragma("unroll") for (int m = 0; m < 4; ++m) _Pragma("unroll") for (int k = 0; k < 2; ++k) dst[m][k] = *(const LAS bf16x8*)(lds + G_SA(b, h) + aoff + m * 2048 + k * 1024); } while (0)
#define G_LDB(dst, b, h) do { _Pragma("unroll") for (int n = 0; n < 2; ++n) _Pragma("unroll") for (int k = 0; k < 2; ++k) dst[n][k] = *(const LAS bf16x8*)(lds + G_SB(b, h) + boff + n * 2048 + k * 1024); } while (0)
#define G_MMA(ai, bj, At, Bt) do { __builtin_amdgcn_s_setprio(1); _Pragma("unroll") for (int m = 0; m < 4; ++m) _Pragma("unroll") for (int n = 0; n < 2; ++n) _Pragma("unroll") for (int k = 0; k < 2; ++k) \
        acc[ai][bj][m][n] = __builtin_amdgcn_mfma_f32_16x16x32_bf16(Bt[n][k], At[m][k], acc[ai][bj][m][n], 0, 0, 0); __builtin_amdgcn_s_setprio(0); } while (0)
#define G_WAIT_V(n) asm volatile("s_waitcnt vmcnt(" #n ")" ::: "memory")
#define G_WAIT_L(n) asm volatile("s_waitcnt lgkmcnt(" #n ")" ::: "memory")
#define G_BAR __builtin_amdgcn_s_barrier()
#define G_SCHED __builtin_amdgcn_sched_barrier(0)
    Unit cur, nxt; int ui = 0;
    if (!unit_next(prob.nM, prob.nN, 0, cur)) return;
    f32x4 acc[2][2][4][2];
    prob.init_acc(acc, cur, wr, wc, fr, fq);
    bf16x8 At[4][2], B0[2][2], B1[2][2];
    const char* cA = prob.a_ptr(cur); const char* cB = prob.b_ptr(cur);
    G_STAGE(G_SB(0, 0), cB, voffB); G_STAGE(G_SA(0, 0), cA, voffA); G_STAGE(G_SB(0, 1), cB + hstepB, voffB); G_STAGE(G_SA(0, 1), cA + hstepA, voffA);
    if (wr == 1) G_BAR;
    G_WAIT_V(4); G_BAR;
    G_STAGE(G_SB(1, 0), cB + kstep, voffB); G_STAGE(G_SA(1, 0), cA + kstep, voffA); G_STAGE(G_SB(1, 1), cB + hstepB + kstep, voffB);
    G_WAIT_V(6); G_BAR;
    for (;;) {
        const bool has_next = unit_next(prob.nM, prob.nN, ui + 1, nxt);
        const char* nA = has_next ? prob.a_ptr(nxt) : cA; const char* nB = has_next ? prob.b_ptr(nxt) : cB;
        for (int t = 0; t < nt; t += 2) {
            const bool last = (t == nt - 2);
            const char* a1 = cA + (size_t)(t + 1) * kstep;
            const char* a2 = last ? nA : cA + (size_t)(t + 2) * kstep; const char* b2 = last ? nB : cB + (size_t)(t + 2) * kstep;
            const char* a3 = a2 + kstep; const char* b3 = b2 + kstep;
            G_LDB(B0, 0, 0); G_SCHED; G_LDA(At, 0, 0); G_STAGE(G_SA(1, 1), a1 + hstepA, voffA);
            G_WAIT_L(8); G_BAR; G_WAIT_L(0); G_MMA(0, 0, At, B0); G_BAR; G_SCHED;
            G_LDB(B1, 0, 1); G_STAGE(G_SB(0, 0), b2, voffB);
            G_BAR; G_WAIT_L(0); G_MMA(0, 1, At, B1); G_BAR;
            G_LDA(At, 0, 1); G_STAGE(G_SA(0, 0), a2, voffA);
            G_BAR; G_WAIT_L(0); G_MMA(1, 0, At, B0); G_BAR; G_SCHED;
            G_STAGE(G_SB(0, 1), b2 + hstepB, voffB);
            G_WAIT_V(6); G_BAR; G_MMA(1, 1, At, B1); G_BAR;
            G_LDB(B0, 1, 0); G_SCHED; G_LDA(At, 1, 0); G_STAGE(G_SA(0, 1), a2 + hstepA, voffA);
            G_WAIT_L(8); G_BAR; G_WAIT_L(0); G_MMA(0, 0, At, B0); G_BAR; G_SCHED;
            G_LDB(B1, 1, 1); G_STAGE(G_SB(1, 0), b3, voffB);
            G_BAR; G_WAIT_L(0); G_MMA(0, 1, At, B1); G_BAR;
            G_LDA(At, 1, 1); G_STAGE(G_SA(1, 0), a3, voffA);
            G_BAR; G_WAIT_L(0); G_MMA(1, 0, At, B0); G_BAR; G_SCHED;
            G_STAGE(G_SB(1, 1), b3 + hstepB, voffB);
            G_WAIT_V(6); G_BAR; G_MMA(1, 1, At, B1); G_BAR;
        }
        prob.epi(acc, cur, wr, wc, fr, fq);
        if (!has_next) break;
        prob.init_acc(acc, nxt, wr, wc, fr, fq);
        cur = nxt; cA = nA; cB = nB; ++ui;
    }
    G_WAIT_V(0);
    if (wr == 0) G_BAR;
    G_BAR;
#undef G_SA
#undef G_SB
#undef G_STAGE
#undef G_LDA
#undef G_LDB
#undef G_MMA
#undef G_WAIT_V
#undef G_WAIT_L
#undef G_BAR
#undef G_SCHED
}

#define EPI_ROWS(u) const int row0 = (u).pm * BM + wr * 64 + fr
#define EPI_FOR_RM _Pragma("unroll") for (int ai = 0; ai < 2; ++ai) _Pragma("unroll") for (int m = 0; m < 4; ++m)

#define PK8(v0, v1) ((u32x4){pk2((v0)[0], (v0)[1]), pk2((v0)[2], (v0)[3]), pk2((v1)[0], (v1)[1]), pk2((v1)[2], (v1)[3])})
struct ProbStoreBf16 {
    static constexpr bool PERM = true;
    int nM, nN, nt, lda, ldb;
    const bf16_t* A; const bf16_t* Bt; bf16_t* O; int ldo;
    __device__ __forceinline__ void init_acc(f32x4 (&acc)[2][2][4][2], const Unit&, int, int, int, int) const {
#pragma unroll
        for (int a = 0; a < 2; ++a)
#pragma unroll
            for (int b = 0; b < 2; ++b)
#pragma unroll
                for (int m = 0; m < 4; ++m)
#pragma unroll
                    for (int n = 0; n < 2; ++n) acc[a][b][m][n] = (f32x4){0.f, 0.f, 0.f, 0.f};
    }
    __device__ __forceinline__ const char* a_ptr(const Unit& u) const { return (const char*)(A + (size_t)u.pm * BM * lda); }
    __device__ __forceinline__ const char* b_ptr(const Unit& u) const { return (const char*)(Bt + (size_t)u.pn * BM * ldb); }
    __device__ __forceinline__ void epi(const f32x4 (&acc)[2][2][4][2], const Unit& u, int wr, int wc, int fr, int fq) const {
        EPI_ROWS(u); const int col0 = u.pn * BM + wc * 32 + 8 * fq;
        EPI_FOR_RM { bf16_t* rowp = O + (size_t)(row0 + ai * HALF + m * 16) * ldo + col0;
#pragma unroll
            for (int bj = 0; bj < 2; ++bj) { const f32x4 v0 = acc[ai][bj][m][0], v1 = acc[ai][bj][m][1];
                u32x4 o; o.x = pk2(v0[0], v0[1]); o.y = pk2(v0[2], v0[3]); o.z = pk2(v1[0], v1[1]); o.w = pk2(v1[2], v1[3]);
                *(u32x4*)(rowp + bj * HALF) = o; } }
    }
};
struct ProbResid {
    static constexpr bool PERM = true;
    int nM, nN, nt, lda, ldb;
    const bf16_t* A; const bf16_t* Bt; const void* xin; void* xout; int in_bf, out_bf;
    __device__ __forceinline__ void init_acc(f32x4 (&acc)[2][2][4][2], const Unit& u, int wr, int wc, int fr, int fq) const {
        EPI_ROWS(u); const int col0 = u.pn * BM + wc * 32 + 8 * fq;
        if (in_bf) {
#pragma unroll
            for (int ai = 0; ai < 2; ++ai)
#pragma unroll
                for (int bj = 0; bj < 2; ++bj)
#pragma unroll
                    for (int m = 0; m < 4; ++m) { const u32x4 r = *(const u32x4*)((const bf16_t*)xin + (size_t)(row0 + ai * HALF + m * 16) * Dm + col0 + bj * HALF);
                        acc[ai][bj][m][0] = (f32x4){bf_lo(r.x), bf_hi(r.x), bf_lo(r.y), bf_hi(r.y)}; acc[ai][bj][m][1] = (f32x4){bf_lo(r.z), bf_hi(r.z), bf_lo(r.w), bf_hi(r.w)}; }
        } else {
#pragma unroll
            for (int ai = 0; ai < 2; ++ai)
#pragma unroll
                for (int bj = 0; bj < 2; ++bj)
#pragma unroll
                    for (int m = 0; m < 4; ++m)
#pragma unroll
                        for (int n = 0; n < 2; ++n) acc[ai][bj][m][n] = *(const f32x4*)((const float*)xin + (size_t)(row0 + ai * HALF + m * 16) * Dm + col0 + bj * HALF + 4 * n);
        }
    }
    __device__ __forceinline__ const char* a_ptr(const Unit& u) const { return (const char*)(A + (size_t)u.pm * BM * lda); }
    __device__ __forceinline__ const char* b_ptr(const Unit& u) const { return (const char*)(Bt + (size_t)u.pn * BM * ldb); }
    __device__ __forceinline__ void epi(const f32x4 (&acc)[2][2][4][2], const Unit& u, int wr, int wc, int fr, int fq) const {
        EPI_ROWS(u); const int col0 = u.pn * BM + wc * 32 + 8 * fq;
        if (out_bf) {
            EPI_FOR_RM { const size_t ro = (size_t)(row0 + ai * HALF + m * 16) * Dm + col0;
#pragma unroll
                for (int bj = 0; bj < 2; ++bj) *(u32x4*)((bf16_t*)xout + ro + bj * HALF) = PK8(acc[ai][bj][m][0], acc[ai][bj][m][1]); }
        } else {
            EPI_FOR_RM { const size_t ro = (size_t)(row0 + ai * HALF + m * 16) * Dm + col0;
#pragma unroll
                for (int bj = 0; bj < 2; ++bj)
#pragma unroll
                    for (int n = 0; n < 2; ++n) *(f32x4*)((float*)xout + ro + bj * HALF + 4 * n) = acc[ai][bj][m][n]; }
        }
    }
};
struct ProbRwkvIn {
    static constexpr bool PERM = true;
    int nM, nN, nt, lda, ldb;
    int round;
    const bf16_t* A0; long dA1, dA2;
    const bf16_t* Wt;
    bf16_t* O0; long dO1, dO2, dO3; bf16_t* lora;
    __device__ __forceinline__ void init_acc(f32x4 (&acc)[2][2][4][2], const Unit&, int, int, int, int) const {
#pragma unroll
        for (int a = 0; a < 2; ++a)
#pragma unroll
            for (int b = 0; b < 2; ++b)
#pragma unroll
                for (int m = 0; m < 4; ++m)
#pragma unroll
                    for (int n = 0; n < 2; ++n) acc[a][b][m][n] = (f32x4){0.f, 0.f, 0.f, 0.f};
    }
    __device__ __forceinline__ int mixsel(const Unit& u) const { return (round == 0) ? ((u.pn == 24) ? 2 : (u.pn >> 3)) : ((u.pn < 8) ? 0 : (u.pn == 8) ? 1 : 2); }
    __device__ __forceinline__ bool is_lora(const Unit& u) const { return (round == 0) ? (u.pn == 24) : (u.pn >= 8); }
    __device__ __forceinline__ const char* a_ptr(const Unit& u) const {
        const int j = mixsel(u);
        return (const char*)(A0 + ((j == 1) ? dA1 : (j == 2) ? dA2 : 0L) + (size_t)u.pm * BM * lda); }
    __device__ __forceinline__ const char* b_ptr(const Unit& u) const {
        size_t rowoff;
        if (round == 0) rowoff = (u.pn == 24) ? (size_t)(10240 + 512) : (size_t)u.pn * BM;
        else rowoff = (u.pn < 8) ? (size_t)(6144 + u.pn * BM) : (size_t)(10240 + (u.pn - 8) * BM);
        return (const char*)(Wt + rowoff * 2048); }
    __device__ __forceinline__ void epi(const f32x4 (&acc)[2][2][4][2], const Unit& u, int wr, int wc, int fr, int fq) const {
        EPI_ROWS(u);
        if (is_lora(u)) {
            const int lim = (round == 0) ? 64 : 96, cb = (round == 0) ? 192 : (u.pn - 8) * 96; const bool th = (round == 1 && u.pn == 8);
            const int c = wc * 32 + 8 * fq;
            if (c < lim) {
                if (th) {
                    EPI_FOR_RM { bf16_t* rowp = lora + (size_t)(row0 + ai * HALF + m * 16) * 256 + cb + c; f32x4 a = acc[ai][0][m][0], b = acc[ai][0][m][1];
#pragma unroll
                        for (int j = 0; j < 4; ++j) { a[j] = 1.f - 2.f / (__expf(2.f * a[j]) + 1.f); b[j] = 1.f - 2.f / (__expf(2.f * b[j]) + 1.f); }
                        *(u32x4*)rowp = PK8(a, b); }
                } else {
                    EPI_FOR_RM { bf16_t* rowp = lora + (size_t)(row0 + ai * HALF + m * 16) * 256 + cb + c; const f32x4 a = acc[ai][0][m][0], b = acc[ai][0][m][1];
                        *(u32x4*)rowp = PK8(a, b); }
                }
            }
            return;
        }
        const int j = (round == 0) ? (u.pn >> 3) : 3;
        bf16_t* O = O0 + ((j == 1) ? dO1 : (j == 2) ? dO2 : (j == 3) ? dO3 : 0L); const int col0 = (u.pn & 7) * BM + wc * 32 + 8 * fq;
        EPI_FOR_RM { bf16_t* rowp = O + (size_t)(row0 + ai * HALF + m * 16) * Dm + col0;
#pragma unroll
            for (int bj = 0; bj < 2; ++bj) *(u32x4*)(rowp + bj * HALF) = PK8(acc[ai][bj][m][0], acc[ai][bj][m][1]); }
    }
};
struct ProbRwkvUp {
    static constexpr bool PERM = true;
    int nM, nN, nt, lda, ldb;
    const bf16_t* A; const bf16_t* Bt;
    const float* w0; long d_a0, d_v0;
    bf16_t* E; bf16_t* AL; bf16_t* V; const bf16_t* VF;
    __device__ __forceinline__ void init_acc(f32x4 (&acc)[2][2][4][2], const Unit& u, int wr, int wc, int fr, int fq) const {
        const int kind = u.pn >> 3; const int col0 = (u.pn & 7) * BM + wc * 32 + 8 * fq;
        const float* bias = w0 + (kind == 1 ? d_a0 : kind == 2 ? d_v0 : 0L);
#pragma unroll
        for (int b = 0; b < 2; ++b)
#pragma unroll
            for (int n = 0; n < 2; ++n) { const f32x4 bvv = *(const f32x4*)(bias + col0 + b * HALF + 4 * n);
#pragma unroll
                for (int a = 0; a < 2; ++a)
#pragma unroll
                    for (int m = 0; m < 4; ++m) acc[a][b][m][n] = bvv; }
    }
    __device__ __forceinline__ const char* a_ptr(const Unit& u) const { return (const char*)(A + (size_t)u.pm * BM * lda); }
    __device__ __forceinline__ const char* b_ptr(const Unit& u) const { return (const char*)(Bt + (size_t)u.pn * BM * ldb); }
    __device__ __forceinline__ void epi(const f32x4 (&acc)[2][2][4][2], const Unit& u, int wr, int wc, int fr, int fq) const {
        EPI_ROWS(u); const int kind = u.pn >> 3; const int col0 = (u.pn & 7) * BM + wc * 32 + 8 * fq;
        if (kind == 0) {
            EPI_FOR_RM { const size_t ro = (size_t)(row0 + ai * HALF + m * 16) * Dm + col0;
#pragma unroll
                for (int bj = 0; bj < 2; ++bj) { f32x4 a = acc[ai][bj][m][0], b = acc[ai][bj][m][1];
#pragma unroll
                    for (int j = 0; j < 4; ++j) { a[j] = 0.6065306597126334f * sigmoidf_(a[j]); b[j] = 0.6065306597126334f * sigmoidf_(b[j]); }
                    u32x4 o; o.x = pkh2(a[0], a[1]); o.y = pkh2(a[2], a[3]); o.z = pkh2(b[0], b[1]); o.w = pkh2(b[2], b[3]);
                    *(u32x4*)(E + ro + bj * HALF) = o; } }
        } else if (kind == 1) {
            EPI_FOR_RM { const size_t ro = (size_t)(row0 + ai * HALF + m * 16) * Dm + col0;
#pragma unroll
                for (int bj = 0; bj < 2; ++bj) { f32x4 a = acc[ai][bj][m][0], b = acc[ai][bj][m][1];
#pragma unroll
                    for (int j = 0; j < 4; ++j) { a[j] = sigmoidf_(a[j]); b[j] = sigmoidf_(b[j]); }
                    u32x4 o; o.x = pkh2(a[0], a[1]); o.y = pkh2(a[2], a[3]); o.z = pkh2(b[0], b[1]); o.w = pkh2(b[2], b[3]);
                    *(u32x4*)(AL + ro + bj * HALF) = o; } }
        } else {
            EPI_FOR_RM { const size_t ro = (size_t)(row0 + ai * HALF + m * 16) * Dm + col0;
#pragma unroll
                for (int bj = 0; bj < 2; ++bj) { f32x4 a = acc[ai][bj][m][0], b = acc[ai][bj][m][1];
                    const u32x4 vv = *(const u32x4*)(V + ro + bj * HALF), vf = *(const u32x4*)(VF + ro + bj * HALF);
                    u32x4 o;
                    { const float p0 = bf_lo(vv.x), p1 = bf_hi(vv.x); o.x = pk2(p0 + (bf_lo(vf.x) - p0) * sigmoidf_(a[0]), p1 + (bf_hi(vf.x) - p1) * sigmoidf_(a[1])); }
                    { const float p0 = bf_lo(vv.y), p1 = bf_hi(vv.y); o.y = pk2(p0 + (bf_lo(vf.y) - p0) * sigmoidf_(a[2]), p1 + (bf_hi(vf.y) - p1) * sigmoidf_(a[3])); }
                    { const float p0 = bf_lo(vv.z), p1 = bf_hi(vv.z); o.z = pk2(p0 + (bf_lo(vf.z) - p0) * sigmoidf_(b[0]), p1 + (bf_hi(vf.z) - p1) * sigmoidf_(b[1])); }
                    { const float p0 = bf_lo(vv.w), p1 = bf_hi(vv.w); o.w = pk2(p0 + (bf_lo(vf.w) - p0) * sigmoidf_(b[2]), p1 + (bf_hi(vf.w) - p1) * sigmoidf_(b[3])); }
                    *(u32x4*)(V + ro + bj * HALF) = o; } }
        }
    }
};
struct ProbPoolGrp {
    static constexpr bool PERM = true;
    int nM, nN, nt, lda, ldb;
    const bf16_t* A; const bf16_t* Bt; const float* scale; const bf16_t* UG; bf16_t* Z;
    __device__ __forceinline__ void init_acc(f32x4 (&acc)[2][2][4][2], const Unit&, int, int, int, int) const {
#pragma unroll
        for (int a = 0; a < 2; ++a)
#pragma unroll
            for (int b = 0; b < 2; ++b)
#pragma unroll
                for (int m = 0; m < 4; ++m)
#pragma unroll
                    for (int n = 0; n < 2; ++n) acc[a][b][m][n] = (f32x4){0.f, 0.f, 0.f, 0.f};
    }
    __device__ __forceinline__ const char* a_ptr(const Unit& u) const { return (const char*)(A + (size_t)u.pm * BM * lda + (u.pn >> 1) * 512); }
    __device__ __forceinline__ const char* b_ptr(const Unit& u) const { return (const char*)(Bt + (size_t)u.pn * BM * ldb); }
    __device__ __forceinline__ void epi(const f32x4 (&acc)[2][2][4][2], const Unit& u, int wr, int wc, int fr, int fq) const {
        EPI_ROWS(u); const int col0 = u.pn * BM + wc * 32 + 8 * fq;
        f32x4 sv[2][2];
#pragma unroll
        for (int bj = 0; bj < 2; ++bj) { sv[bj][0] = *(const f32x4*)(scale + col0 + bj * HALF); sv[bj][1] = *(const f32x4*)(scale + col0 + bj * HALF + 4); }
        EPI_FOR_RM { const size_t r = (size_t)(row0 + ai * HALF + m * 16);
#pragma unroll
            for (int bj = 0; bj < 2; ++bj) { const f32x4 v0 = acc[ai][bj][m][0] * sv[bj][0], v1 = acc[ai][bj][m][1] * sv[bj][1];
                const u32x4 gg = *(const u32x4*)(UG + r * 4096 + 2048 + col0 + bj * HALF);
                u32x4 o; o.x = pk2(v0[0] * siluf_(bf_lo(gg.x)), v0[1] * siluf_(bf_hi(gg.x))); o.y = pk2(v0[2] * siluf_(bf_lo(gg.y)), v0[3] * siluf_(bf_hi(gg.y)));
                o.z = pk2(v1[0] * siluf_(bf_lo(gg.z)), v1[1] * siluf_(bf_hi(gg.z))); o.w = pk2(v1[2] * siluf_(bf_lo(gg.w)), v1[3] * siluf_(bf_hi(gg.w)));
                *(u32x4*)(Z + r * Dm + col0 + bj * HALF) = o; } }
    }
};

__device__ __forceinline__ void transpose_item(const float* W, int sld, int N, bf16_t* WT, int dld, LAS float* scr, int item, int lane) {
    const int nblk = N / 32, kb = item / nblk, nb = item % nblk, k0 = 64 * kb, n0 = 32 * nb;
#pragma unroll 8
    for (int i = 0; i < 32; ++i) { const int kk = 2 * i + (lane >> 5); scr[kk * 33 + (lane & 31)] = W[(size_t)(k0 + kk) * sld + n0 + (lane & 31)]; }
    __builtin_amdgcn_fence(__ATOMIC_RELEASE, "wavefront"); __builtin_amdgcn_wave_barrier();
    const int c = lane & 7;
#pragma unroll
    for (int j = 0; j < 4; ++j) { const int n = (lane >> 3) + 8 * j; const LAS float* s = scr + (8 * c) * 33 + n;
        u32x4 o; o.x = pk2(s[0 * 33], s[1 * 33]); o.y = pk2(s[2 * 33], s[3 * 33]); o.z = pk2(s[4 * 33], s[5 * 33]); o.w = pk2(s[6 * 33], s[7 * 33]);
        *(u32x4*)(WT + (size_t)(n0 + n) * dld + k0 + 8 * c) = o; }
    __builtin_amdgcn_fence(__ATOMIC_RELEASE, "wavefront"); __builtin_amdgcn_wave_barrier();
}
struct TrJob { const float* W; int K, N, sld; bf16_t* WT; int dld; };
template <int NJ>
__device__ __forceinline__ void run_transposes(int tid, const TrJob (&jobs)[NJ], LAS unsigned char* lds) {
    const int wave = tid >> 6, lane = tid & 63, gw = blockIdx.x * NWAVE + wave, NGW = gridDim.x * NWAVE;
    LAS float* scr = (LAS float*)(lds + wave * 8448);
    int total = 0;
#pragma unroll
    for (int j = 0; j < NJ; ++j) total += (jobs[j].K / 64) * (jobs[j].N / 32);
    for (int it = gw; it < total; it += NGW) {
        int r = it;
#pragma unroll
        for (int j = 0; j < NJ; ++j) { const int cnt = (jobs[j].K / 64) * (jobs[j].N / 32);
            if (r >= 0 && r < cnt) transpose_item(jobs[j].W, jobs[j].sld, jobs[j].N, jobs[j].WT, jobs[j].dld, scr, r, lane);
            r -= cnt; }
    }
}

__device__ __forceinline__ void rwkv_weights(int tid, const Params& p, int ia, bool has_v, LAS unsigned char* lds) {
    bf16_t* Wt = (bf16_t*)(p.ws + WS_W);
    const float* win = p.in[4] + (size_t)ia * 4 * Dm * Dm;
    TrJob jobs[5];
#pragma unroll
    for (int j = 0; j < 4; ++j) jobs[j] = TrJob{win + (size_t)j * Dm * Dm, Dm, Dm, Dm, Wt + (size_t)j * Dm * Dm, Dm};
    jobs[4] = TrJob{p.in[19] + (size_t)ia * Dm * Dm, Dm, Dm, Dm, Wt + (size_t)8192 * 2048, Dm};
    run_transposes<5>(tid, jobs, lds);
    const float* w1 = p.in[6] + (size_t)ia * Dm * 96; const float* w2 = p.in[7] + (size_t)ia * 96 * Dm;
    const float* a1 = p.in[9] + (size_t)ia * Dm * 96; const float* a2 = p.in[10] + (size_t)ia * 96 * Dm;
    const float* v1 = p.in[17]; const float* v2 = p.in[18];
    bf16_t* Wd = Wt + (size_t)10240 * 2048; bf16_t* Wu = Wt + (size_t)11008 * 2048;
    const long gt = (long)blockIdx.x * NTHR + tid, GT = (long)gridDim.x * NTHR;
    const int ndt = has_v ? 3 : 2;
    for (long i = gt; i < (long)ndt * 256 * 256; i += GT) {
        const int n = (int)(i & 255), k8 = (int)((i >> 8) & 255), tile = (int)(i >> 16);
        const float* src = tile == 0 ? w1 : tile == 1 ? a1 : v1; const int rank = tile == 2 ? 64 : 96;
        float v[8];
#pragma unroll
        for (int j = 0; j < 8; ++j) v[j] = (n < rank) ? src[(size_t)(k8 * 8 + j) * rank + n] : 0.f;
        u32x4 o; o.x = pk2(v[0], v[1]); o.y = pk2(v[2], v[3]); o.z = pk2(v[4], v[5]); o.w = pk2(v[6], v[7]);
        *(u32x4*)(Wd + ((size_t)tile * 256 + n) * 2048 + k8 * 8) = o;
    }
    const int nup = has_v ? 6144 : 4096;
    for (long i = gt; i < (long)nup * 32; i += GT) {
        const int n = (int)(i % nup), k8 = (int)(i / nup), kind = n >> 11, nn = n & 2047;
        const float* src = kind == 0 ? w2 : kind == 1 ? a2 : v2; const int klo = kind * 96, rank = kind == 2 ? 64 : 96;
        float v[8];
#pragma unroll
        for (int j = 0; j < 8; ++j) { const int k = k8 * 8 + j - klo; v[j] = (k >= 0 && k < rank) ? src[(size_t)k * Dm + nn] : 0.f; }
        u32x4 o; o.x = pk2(v[0], v[1]); o.y = pk2(v[2], v[3]); o.z = pk2(v[4], v[5]); o.w = pk2(v[6], v[7]);
        *(u32x4*)(Wu + (size_t)n * 256 + k8 * 8) = o;
    }
}
template <bool XBF> __device__ __forceinline__ void ldrow8(const void* x, size_t t, int ck, f32x4& a, f32x4& b) {
    if (XBF) { const u32x4 r = __builtin_nontemporal_load((const u32x4*)((const bf16_t*)x + t * Dm) + ck);
        a = (f32x4){bf_lo(r.x), bf_hi(r.x), bf_lo(r.y), bf_hi(r.y)}; b = (f32x4){bf_lo(r.z), bf_hi(r.z), bf_lo(r.w), bf_hi(r.w)}; }
    else { const f32x4* p_ = (const f32x4*)((const float*)x + t * Dm) + 2 * ck; a = __builtin_nontemporal_load(p_); b = __builtin_nontemporal_load(p_ + 1); }
}
__device__ __forceinline__ float sq8(const f32x4& a, const f32x4& b) { return ((a.x * a.x + a.y * a.y) + (a.z * a.z + a.w * a.w)) + ((b.x * b.x + b.y * b.y) + (b.z * b.z + b.w * b.w)); }
template <int NMIX, bool XBF>
__device__ __forceinline__ void norm_mix_phase(int tid, const void* x, const float* nw, const float* mu0, const float* mu1, bf16_t* O0, bf16_t* O1, const float* mu2 = nullptr, bf16_t* O2 = nullptr) {
    const int wave = tid >> 6, lane = tid & 63, gw = blockIdx.x * NWAVE + wave, NGW = gridDim.x * NWAVE;
    for (int ch = gw; ch < T / 16; ch += NGW) {
        const int t0 = ch * 16;
        f32x4 hp[4][2];
        if (NMIX) {
            if ((t0 % SEQ) != 0) {
                float s = 0.f;
#pragma unroll
                for (int j = 0; j < 4; ++j) { ldrow8<XBF>(x, (size_t)(t0 - 1), lane + 64 * j, hp[j][0], hp[j][1]); s += sq8(hp[j][0], hp[j][1]); }
                const float rstd = rsqrtf(wave_sum(s) * (1.f / Dm) + RMS_EPS);
#pragma unroll
                for (int j = 0; j < 4; ++j) { hp[j][0] = hp[j][0] * rstd * ((const f32x4*)nw)[2 * (lane + 64 * j)]; hp[j][1] = hp[j][1] * rstd * ((const f32x4*)nw)[2 * (lane + 64 * j) + 1]; }
            } else {
#pragma unroll
                for (int j = 0; j < 4; ++j) { hp[j][0] = (f32x4){0.f, 0.f, 0.f, 0.f}; hp[j][1] = hp[j][0]; }
            }
        }
        f32x4 xn[4][2];
#pragma unroll
        for (int j = 0; j < 4; ++j) ldrow8<XBF>(x, (size_t)t0, lane + 64 * j, xn[j][0], xn[j][1]);
        for (int r = 0; r < 16; ++r) {
            const int t = t0 + r;
            f32x4 h[4][2]; float s = 0.f;
#pragma unroll
            for (int j = 0; j < 4; ++j) { h[j][0] = xn[j][0]; h[j][1] = xn[j][1]; s += sq8(h[j][0], h[j][1]); }
            if (r + 1 < 16) {
#pragma unroll
                for (int j = 0; j < 4; ++j) ldrow8<XBF>(x, (size_t)(t + 1), lane + 64 * j, xn[j][0], xn[j][1]); }
            const float rstd = rsqrtf(wave_sum(s) * (1.f / Dm) + RMS_EPS);
#pragma unroll
            for (int j = 0; j < 4; ++j) { h[j][0] = h[j][0] * rstd * ((const f32x4*)nw)[2 * (lane + 64 * j)]; h[j][1] = h[j][1] * rstd * ((const f32x4*)nw)[2 * (lane + 64 * j) + 1]; }
            if (NMIX) {
#pragma unroll
                for (int j = 0; j < 4; ++j) {
                    const int ck = lane + 64 * j;
                    const f32x4 d0 = hp[j][0] - h[j][0], d1 = hp[j][1] - h[j][1];
                    const f32x4 a0 = h[j][0] + d0 * ((const f32x4*)mu0)[2 * ck], a1 = h[j][1] + d1 * ((const f32x4*)mu0)[2 * ck + 1];
                    const f32x4 b0 = h[j][0] + d0 * ((const f32x4*)mu1)[2 * ck], b1 = h[j][1] + d1 * ((const f32x4*)mu1)[2 * ck + 1];
                    *((u32x4*)(O0 + (size_t)t * Dm) + ck) = PK8(a0, a1); *((u32x4*)(O1 + (size_t)t * Dm) + ck) = PK8(b0, b1);
                    if (NMIX == 3) { const f32x4 c0 = h[j][0] + d0 * ((const f32x4*)mu2)[2 * ck], c1 = h[j][1] + d1 * ((const f32x4*)mu2)[2 * ck + 1]; *((u32x4*)(O2 + (size_t)t * Dm) + ck) = PK8(c0, c1); }
                    hp[j][0] = h[j][0]; hp[j][1] = h[j][1];
                }
            } else {
#pragma unroll
                for (int j = 0; j < 4; ++j) *((u32x4*)(O0 + (size_t)t * Dm) + lane + 64 * j) = PK8(h[j][0], h[j][1]);
            }
        }
    }
}

constexpr int TC = 16, NCH = SEQ / TC;
constexpr int SC_OPS = 0, SC_VP = 2 * 5 * TC * 64 * 4, SC_BON = SC_VP + 3 * TC * 64 * 4, SC_YB = SC_BON + 3 * TC * 4 + 64, SC_PAIR = SC_YB + 2 * TC * 64 * 4;
static_assert(2 * SC_PAIR <= LDS_BYTES, "scan LDS");
struct ScanOps { f32x4 w[4], a[4], b[4], k[4], r[4]; f32x2 v; };
#define SC_PAIROF(arr, cp) (((cp) & 1) ? __builtin_shufflevector(arr[(cp) >> 1], arr[(cp) >> 1], 2, 3) : __builtin_shufflevector(arr[(cp) >> 1], arr[(cp) >> 1], 0, 1))
#define SC_LOAD(O, s_) do { _Pragma("unroll") for (int q = 0; q < 4; ++q) { O.w[q] = *(const LAS f32x4*)(ob + 0 * TC * 64 + (s_) * 64 + 4 * q); O.a[q] = *(const LAS f32x4*)(ob + 1 * TC * 64 + (s_) * 64 + 4 * q); \
        O.b[q] = *(const LAS f32x4*)(ob + 2 * TC * 64 + (s_) * 64 + 4 * q); O.k[q] = *(const LAS f32x4*)(ob + 3 * TC * 64 + (s_) * 64 + 4 * q); O.r[q] = *(const LAS f32x4*)(ob + 4 * TC * 64 + (s_) * 64 + 4 * q); } \
        O.v = *(const LAS f32x2*)(vb + (s_) * 64); } while (0)
#define SC_STEP(O, s_) do { float sa[2], y[2]; \
        _Pragma("unroll") for (int i = 0; i < 2; ++i) { f32x2 t = S2[i][0] * SC_PAIROF(O.a, 0); \
            _Pragma("unroll") for (int cp = 1; cp < 8; ++cp) t = S2[i][cp] * SC_PAIROF(O.a, cp) + t; \
            sa[i] = quad_sum(t.x + t.y); } \
        _Pragma("unroll") for (int i = 0; i < 2; ++i) { const f32x2 sav = (f32x2){sa[i], sa[i]}, vv = (f32x2){O.v[i], O.v[i]}; f32x2 t; \
            _Pragma("unroll") for (int cp = 0; cp < 8; ++cp) { f32x2 u = sav * SC_PAIROF(O.b, cp); u = vv * SC_PAIROF(O.k, cp) + u; S2[i][cp] = S2[i][cp] * SC_PAIROF(O.w, cp) + u; \
                t = (cp == 0) ? S2[i][0] * SC_PAIROF(O.r, 0) : S2[i][cp] * SC_PAIROF(O.r, cp) + t; } \
            y[i] = quad_sum(t.x + t.y); } \
        if (jg == 0) *(LAS f32x2*)(yb + (s_) * 64) = (f32x2){y[0], y[1]}; } while (0)
__device__ __forceinline__ void scan_phase(int tid, LAS unsigned char* lds, const bf16_t* R, const bf16_t* E, const bf16_t* Kb, const bf16_t* V, const bf16_t* AL, const bf16_t* G,
                                           const float* k_k, const float* k_a, const float* r_k, const float* lnw, const float* lnb, bf16_t* Z) {
    const int wave = __builtin_amdgcn_readfirstlane(tid >> 6), lane = tid & 63;
    const int role = (wave < 4) ? 0 : (wave < 6) ? 1 : 2, pi = (wave < 4) ? (wave >> 1) : (wave & 1), hf = wave & 1;
    LAS unsigned char* base = lds + pi * SC_PAIR;
    LAS float* OPS = (LAS float*)(base + SC_OPS); LAS float* VP = (LAS float*)(base + SC_VP); LAS float* BON = (LAS float*)(base + SC_BON); LAS float* YB = (LAS float*)(base + SC_YB);
    for (int pb = blockIdx.x * 2; pb < NB * 32; pb += gridDim.x * 2) {
        const int pair = pb + pi, b = pair >> 5, h = pair & 31;
        const size_t gbase = (size_t)b * SEQ * Dm + h * 64;
        const int st = lane >> 2, cgp = lane & 3;
        const int ig = lane >> 2, jg = lane & 3;
        if (role == 0) {
            f32x2 S2[2][8];
#pragma unroll
            for (int i = 0; i < 2; ++i)
#pragma unroll
                for (int c = 0; c < 8; ++c) S2[i][c] = (f32x2){0.f, 0.f};
            for (int it = 0; it < NCH + 2; ++it) {
                if (it >= 1 && it <= NCH) {
                    const int c_ = it - 1;
                    const LAS float* ob = OPS + (c_ & 1) * (5 * TC * 64) + 16 * jg;
                    const LAS float* vb = VP + (c_ % 3) * (TC * 64) + 32 * hf + 2 * ig;
                    LAS float* yb = YB + (c_ & 1) * (TC * 64) + 32 * hf + 2 * ig;
                    ScanOps OA, OB;
                    SC_LOAD(OA, 0);
#pragma unroll 1
                    for (int s = 0; s < TC; s += 2) {
                        SC_LOAD(OB, s + 1);
                        SC_STEP(OA, s);
                        if (s + 2 < TC) SC_LOAD(OA, s + 2);
                        SC_STEP(OB, s + 1);
                    }
                }
                __syncthreads();
            }
        } else if (role == 1) {
            float ckk[16], cka[16], crk[16];
            u32x4 raw[10];
#pragma unroll
            for (int c = 0; c < 16; ++c) { ckk[c] = k_k[h * 64 + 16 * cgp + c]; cka[c] = k_a[h * 64 + 16 * cgp + c]; crk[c] = r_k[h * 64 + 16 * cgp + c]; }
            const size_t go = gbase + (size_t)st * Dm + 16 * cgp;
            raw[0] = *(const u32x4*)(R + go); raw[1] = *(const u32x4*)(R + go + 8); raw[2] = *(const u32x4*)(Kb + go); raw[3] = *(const u32x4*)(Kb + go + 8);
            raw[4] = *(const u32x4*)(V + go); raw[5] = *(const u32x4*)(V + go + 8); raw[6] = *(const u32x4*)(E + go); raw[7] = *(const u32x4*)(E + go + 8);
            raw[8] = *(const u32x4*)(AL + go); raw[9] = *(const u32x4*)(AL + go + 8);
          for (int it = 0; it < NCH + 2; ++it) {
            if (it < NCH) {
                const unsigned rw[8] = {raw[0].x, raw[0].y, raw[0].z, raw[0].w, raw[1].x, raw[1].y, raw[1].z, raw[1].w}, kw[8] = {raw[2].x, raw[2].y, raw[2].z, raw[2].w, raw[3].x, raw[3].y, raw[3].z, raw[3].w};
                const unsigned vw[8] = {raw[4].x, raw[4].y, raw[4].z, raw[4].w, raw[5].x, raw[5].y, raw[5].z, raw[5].w}, ew[8] = {raw[6].x, raw[6].y, raw[6].z, raw[6].w, raw[7].x, raw[7].y, raw[7].z, raw[7].w};
                const unsigned aw[8] = {raw[8].x, raw[8].y, raw[8].z, raw[8].w, raw[9].x, raw[9].y, raw[9].z, raw[9].w};
                float rr[16], kk[16], vv[16], ww[16], lr[16], kn[16];
#pragma unroll
                for (int j = 0; j < 8; ++j) { rr[2 * j] = bf_lo(rw[j]); rr[2 * j + 1] = bf_hi(rw[j]); kk[2 * j] = bf_lo(kw[j]); kk[2 * j + 1] = bf_hi(kw[j]);
                    vv[2 * j] = bf_lo(vw[j]); vv[2 * j + 1] = bf_hi(vw[j]); ww[2 * j] = __expf(-h_lo(ew[j])); ww[2 * j + 1] = __expf(-h_hi(ew[j]));
                    lr[2 * j] = h_lo(aw[j]); lr[2 * j + 1] = h_hi(aw[j]); }
                if (it + 1 < NCH) {
                    const size_t go = gbase + (size_t)((it + 1) * TC + st) * Dm + 16 * cgp;
                    raw[0] = *(const u32x4*)(R + go); raw[1] = *(const u32x4*)(R + go + 8); raw[2] = *(const u32x4*)(Kb + go); raw[3] = *(const u32x4*)(Kb + go + 8);
                    raw[4] = *(const u32x4*)(V + go); raw[5] = *(const u32x4*)(V + go + 8); raw[6] = *(const u32x4*)(E + go); raw[7] = *(const u32x4*)(E + go + 8);
                    raw[8] = *(const u32x4*)(AL + go); raw[9] = *(const u32x4*)(AL + go + 8);
                }
                float ss = 0.f;
#pragma unroll
                for (int c = 0; c < 16; ++c) { kn[c] = kk[c] * ckk[c]; ss += kn[c] * kn[c]; }
                ss = quad_sum(ss);
                const float inv = 1.f / fmaxf(sqrtf(ss), 1e-12f);
                float bon = 0.f; float av[16], bv[16], kp[16];
#pragma unroll
                for (int c = 0; c < 16; ++c) { kn[c] *= inv; av[c] = -kn[c]; bv[c] = kn[c] * lr[c]; kp[c] = kk[c] * (1.f + (lr[c] - 1.f) * cka[c]); bon += rr[c] * kp[c] * crk[c]; }
                bon = quad_sum(bon);
                LAS float* ob = OPS + (it & 1) * (5 * TC * 64) + st * 64 + 16 * cgp;
#pragma unroll
                for (int q = 0; q < 4; ++q) {
                    *(LAS f32x4*)(ob + 0 * TC * 64 + 4 * q) = (f32x4){ww[4 * q], ww[4 * q + 1], ww[4 * q + 2], ww[4 * q + 3]};
                    *(LAS f32x4*)(ob + 1 * TC * 64 + 4 * q) = (f32x4){av[4 * q], av[4 * q + 1], av[4 * q + 2], av[4 * q + 3]};
                    *(LAS f32x4*)(ob + 2 * TC * 64 + 4 * q) = (f32x4){bv[4 * q], bv[4 * q + 1], bv[4 * q + 2], bv[4 * q + 3]};
                    *(LAS f32x4*)(ob + 3 * TC * 64 + 4 * q) = (f32x4){kp[4 * q], kp[4 * q + 1], kp[4 * q + 2], kp[4 * q + 3]};
                    *(LAS f32x4*)(ob + 4 * TC * 64 + 4 * q) = (f32x4){rr[4 * q], rr[4 * q + 1], rr[4 * q + 2], rr[4 * q + 3]};
                    *(LAS f32x4*)(VP + (it % 3) * (TC * 64) + st * 64 + 16 * cgp + 4 * q) = (f32x4){vv[4 * q], vv[4 * q + 1], vv[4 * q + 2], vv[4 * q + 3]};
                }
                if (cgp == 0) BON[(it % 3) * TC + st] = bon;
            }
            __syncthreads();
          }
        } else {
            float ckk[16], cka[16];
#pragma unroll
            for (int c = 0; c < 16; ++c) { ckk[c] = lnw[h * 64 + 16 * cgp + c]; cka[c] = lnb[h * 64 + 16 * cgp + c]; }
          for (int it = 0; it < NCH + 2; ++it) {
            if (it >= 2) {
                const int c_ = it - 2;
                const size_t go = gbase + (size_t)(c_ * TC + st) * Dm + 16 * cgp;
                const u32x4 g0 = *(const u32x4*)(G + go), g1 = *(const u32x4*)(G + go + 8);
                const LAS float* yb = YB + (c_ & 1) * (TC * 64) + st * 64 + 16 * cgp;
                const LAS float* vb = VP + (c_ % 3) * (TC * 64) + st * 64 + 16 * cgp;
                float y[16], vv[16];
#pragma unroll
                for (int q = 0; q < 4; ++q) { const f32x4 t = *(const LAS f32x4*)(yb + 4 * q), u = *(const LAS f32x4*)(vb + 4 * q);
                    y[4 * q] = t.x; y[4 * q + 1] = t.y; y[4 * q + 2] = t.z; y[4 * q + 3] = t.w; vv[4 * q] = u.x; vv[4 * q + 1] = u.y; vv[4 * q + 2] = u.z; vv[4 * q + 3] = u.w; }
                const float bon = BON[(c_ % 3) * TC + st];
                float s = 0.f;
#pragma unroll
                for (int c = 0; c < 16; ++c) s += y[c];
                const float mean = quad_sum(s) * (1.f / 64.f);
                float s2 = 0.f;
#pragma unroll
                for (int c = 0; c < 16; ++c) { y[c] -= mean; s2 += y[c] * y[c]; }
                const float rstd = rsqrtf(quad_sum(s2) * (1.f / 64.f) + LN_EPS);
                const unsigned gw_[8] = {g0.x, g0.y, g0.z, g0.w, g1.x, g1.y, g1.z, g1.w}; unsigned ow[8];
#pragma unroll
                for (int j = 0; j < 8; ++j) {
                    const float z0 = (y[2 * j] * rstd * ckk[2 * j] + cka[2 * j] + bon * vv[2 * j]) * siluf_(bf_lo(gw_[j]));
                    const float z1 = (y[2 * j + 1] * rstd * ckk[2 * j + 1] + cka[2 * j + 1] + bon * vv[2 * j + 1]) * siluf_(bf_hi(gw_[j]));
                    ow[j] = pk2(z0, z1); }
                *(u32x4*)(Z + go) = (u32x4){ow[0], ow[1], ow[2], ow[3]}; *(u32x4*)(Z + go + 8) = (u32x4){ow[4], ow[5], ow[6], ow[7]};
            }
            __syncthreads();
          }
        }
    }
}
__device__ __forceinline__ void attn_weights(int tid, const Params& p, LAS unsigned char* lds) {
    bf16_t* Wt = (bf16_t*)(p.ws + WS_W);
    TrJob jobs[2];
    jobs[0] = TrJob{p.in[20], Dm, 10240, 10240, Wt, Dm};
    jobs[1] = TrJob{p.in[23], 1024, Dm, Dm, Wt + (size_t)10240 * 2048, 1024};
    run_transposes<2>(tid, jobs, lds);
    float* COS = (float*)(p.ws + WS_COS); float* SIN = (float*)(p.ws + WS_SIN);
    const long gt = (long)blockIdx.x * NTHR + tid, GT = (long)gridDim.x * NTHR;
    for (long i = gt; i < (long)T * 16; i += GT) {
        const int t = (int)(i >> 4), f = (int)(i & 15);
        const float inv = powf(500000.0f, -(float)(2 * f) / 32.0f);
        const float ang = (float)p.positions[t] * inv; float s, c; sincosf(ang, &s, &c);
        COS[i] = c; SIN[i] = s;
    }
}
__device__ __forceinline__ void pool_weights(int tid, const Params& p, LAS unsigned char* lds) {
    bf16_t* Wt = (bf16_t*)(p.ws + WS_W);
    TrJob jobs[6];
    jobs[0] = TrJob{p.in[24], Dm, 4096, 4096, Wt, Dm};
#pragma unroll
    for (int g = 0; g < 4; ++g) jobs[1 + g] = TrJob{p.in[25] + (size_t)g * 512 * 512, 512, 512, 512, Wt + (size_t)4096 * 2048 + (size_t)g * 512 * 512, 512};
    jobs[5] = TrJob{p.in[27], Dm, Dm, Dm, Wt + (size_t)4096 * 2048 + (size_t)2048 * 512, Dm};
    run_transposes<6>(tid, jobs, lds);
}

__device__ __forceinline__ unsigned off_b(unsigned row, unsigned ch) { return 256u * row + 16u * (ch ^ (((row & 3) << 2) | ((row >> 2) & 3))); }
__device__ __forceinline__ void attn_phase(int tid, LAS unsigned char* lds, bf16_t* QKVG, float* LSE, const float* qn_w, const float* kn_w, const float* COS, const float* SIN) {
    const int w = __builtin_amdgcn_readfirstlane(tid >> 6), lane = tid & 63, fr = lane & 15, g4 = lane >> 4;
    LAS unsigned char* Kt = lds; LAS unsigned char* Vt = lds + 65536;
    const float scale = 0.08838834764831845f;
    for (int item = blockIdx.x; item < NB * 8 * 48; item += gridDim.x) {
        const int bh = item / 48, r = item % 48, b = bh >> 3, hh = bh & 7;
        int g, dil, rho, n;
        if (r < 16) { g = 0; dil = 1; rho = 0; n = r; } else if (r < 32) { g = 1; dil = 4; rho = (r - 16) >> 2; n = (r - 16) & 3; } else { g = 2; dil = 16; rho = r - 32; n = 0; }
        const int qcol = (g * 8 + hh) * 128, kcol = 3072 + qcol, vcol = 6144 + qcol;
        const size_t tok0 = (size_t)b * SEQ + rho;
        __syncthreads();
        {
            const int ch = tid & 15; const float sgk = (ch < 2) ? -1.f : 1.f;
            const f32x4 kw0 = *(const f32x4*)(kn_w + g * 128 + ch * 8), kw1 = *(const f32x4*)(kn_w + g * 128 + ch * 8 + 4);
            const float kwv[8] = {kw0.x, kw0.y, kw0.z, kw0.w, kw1.x, kw1.y, kw1.z, kw1.w};
#pragma unroll
            for (int ih = 0; ih < 2; ++ih) {
                u32x4 kv[4], vv[4]; f32x4 cs[4][4];
#pragma unroll
                for (int i2 = 0; i2 < 4; ++i2) {
                    const int row = (tid >> 4) + 32 * (4 * ih + i2), s = 128 * (n - 1) + row;
                    kv[i2] = (u32x4){0u, 0u, 0u, 0u}; vv[i2] = kv[i2];
#pragma unroll
                    for (int q = 0; q < 4; ++q) cs[i2][q] = (f32x4){0.f, 0.f, 0.f, 0.f};
                    if (s >= 0) { const size_t tk = tok0 + (size_t)dil * s; const bf16_t* src = QKVG + tk * 10240 + ch * 8; kv[i2] = *(const u32x4*)(src + kcol); vv[i2] = *(const u32x4*)(src + vcol);
                        if (ch < 4) { const float* cp = COS + tk * 16 + (ch & 1) * 8; const float* sp = SIN + tk * 16 + (ch & 1) * 8;
                            cs[i2][0] = *(const f32x4*)cp; cs[i2][1] = *(const f32x4*)(cp + 4); cs[i2][2] = *(const f32x4*)sp; cs[i2][3] = *(const f32x4*)(sp + 4); } }
                }
#pragma unroll
                for (int i2 = 0; i2 < 4; ++i2) {
                    const int row = (tid >> 4) + 32 * (4 * ih + i2);
                    const unsigned rw[4] = {kv[i2].x, kv[i2].y, kv[i2].z, kv[i2].w};
                    float x[8]; float ss = 0.f;
#pragma unroll
                    for (int j = 0; j < 4; ++j) { x[2 * j] = bf_lo(rw[j]); x[2 * j + 1] = bf_hi(rw[j]); ss += x[2 * j] * x[2 * j] + x[2 * j + 1] * x[2 * j + 1]; }
                    const float rstd = rsqrtf(row16_sum(ss) * (1.f / 128.f) + RMS_EPS);
                    const float cv[8] = {cs[i2][0].x, cs[i2][0].y, cs[i2][0].z, cs[i2][0].w, cs[i2][1].x, cs[i2][1].y, cs[i2][1].z, cs[i2][1].w};
                    const float sv[8] = {cs[i2][2].x, cs[i2][2].y, cs[i2][2].z, cs[i2][2].w, cs[i2][3].x, cs[i2][3].y, cs[i2][3].z, cs[i2][3].w};
#pragma unroll
                    for (int j = 0; j < 8; ++j) { x[j] = x[j] * rstd * kwv[j];
                        const float px = __int_as_float(__builtin_amdgcn_update_dpp(0, __float_as_int(x[j]), 0x4E, 0xF, 0xF, true));
                        x[j] = (ch < 4) ? x[j] * cv[j] + sgk * px * sv[j] : x[j]; }
                    u32x4 ko; ko.x = pk2(x[0], x[1]); ko.y = pk2(x[2], x[3]); ko.z = pk2(x[4], x[5]); ko.w = pk2(x[6], x[7]);
                    *(LAS u32x4*)(Kt + off_b(row, ch)) = ko; *(LAS u32x4*)(Vt + off_b(row, ch)) = vv[i2];
                }
            }
        }
        const size_t qtok = tok0 + (size_t)dil * (128 * n + 16 * w + fr);
        bf16x8 qf[4];
        {
            u32x4 qr[4]; f32x4 qw[4][2];
#pragma unroll
            for (int ks = 0; ks < 4; ++ks) { qr[ks] = *(const u32x4*)(QKVG + qtok * 10240 + qcol + 32 * ks + 8 * g4);
                qw[ks][0] = *(const f32x4*)(qn_w + g * 128 + 32 * ks + 8 * g4); qw[ks][1] = *(const f32x4*)(qn_w + g * 128 + 32 * ks + 8 * g4 + 4); }
            const float* cp = COS + qtok * 16 + (g4 & 1) * 8; const float* sp = SIN + qtok * 16 + (g4 & 1) * 8;
            const f32x4 c0 = *(const f32x4*)cp, c1 = *(const f32x4*)(cp + 4), s0 = *(const f32x4*)sp, s1 = *(const f32x4*)(sp + 4);
            float x[4][8]; float ss = 0.f;
#pragma unroll
            for (int ks = 0; ks < 4; ++ks) { const unsigned rw[4] = {qr[ks].x, qr[ks].y, qr[ks].z, qr[ks].w};
#pragma unroll
                for (int j = 0; j < 4; ++j) { x[ks][2 * j] = bf_lo(rw[j]); x[ks][2 * j + 1] = bf_hi(rw[j]); ss += x[ks][2 * j] * x[ks][2 * j] + x[ks][2 * j + 1] * x[ks][2 * j + 1]; } }
            ss += __shfl_xor(ss, 16); ss += __shfl_xor(ss, 32);
            const float rstd = rsqrtf(ss * (1.f / 128.f) + RMS_EPS);
#pragma unroll
            for (int ks = 0; ks < 4; ++ks)
#pragma unroll
                for (int j = 0; j < 8; ++j) x[ks][j] = x[ks][j] * rstd * qw[ks][j >> 2][j & 3];
            const float cv[8] = {c0.x, c0.y, c0.z, c0.w, c1.x, c1.y, c1.z, c1.w}, sv[8] = {s0.x, s0.y, s0.z, s0.w, s1.x, s1.y, s1.z, s1.w};
            const float sgq = (g4 < 2) ? -1.f : 1.f;
#pragma unroll
            for (int j = 0; j < 8; ++j) { const float px = __shfl_xor(x[0][j], 32); x[0][j] = x[0][j] * cv[j] + sgq * px * sv[j]; }
#pragma unroll
            for (int ks = 0; ks < 4; ++ks) { u32x4 t; t.x = pk2(x[ks][0], x[ks][1]); t.y = pk2(x[ks][2], x[ks][3]); t.z = pk2(x[ks][4], x[ks][5]); t.w = pk2(x[ks][6], x[ks][7]); qf[ks] = __builtin_bit_cast(bf16x8, t); }
        }
        __syncthreads();
        f32x4 sacc[9];
#pragma unroll
        for (int kbi = 0; kbi < 9; ++kbi) { sacc[kbi] = (f32x4){0.f, 0.f, 0.f, 0.f};
#pragma unroll
            for (int ks = 0; ks < 4; ++ks) { const bf16x8 kf = *(const LAS bf16x8*)(Kt + off_b(16 * (w + kbi) + fr, 4 * ks + g4));
                sacc[kbi] = __builtin_amdgcn_mfma_f32_16x16x32_bf16(kf, qf[ks], sacc[kbi], 0, 0, 0); } }
        const int qi = 16 * w + fr;
        float mx = -3.0e38f;
#pragma unroll
        for (int kbi = 0; kbi < 9; ++kbi)
#pragma unroll
            for (int j = 0; j < 4; ++j) { const int kj = 16 * (w + kbi) + 4 * g4 + j; const bool ok = (kj >= qi) && (kj <= qi + 128) && (n > 0 || kj >= 128);
                const float sv = ok ? sacc[kbi][j] * scale : -3.0e38f; sacc[kbi][j] = sv; mx = fmaxf(mx, sv); }
        mx = fmaxf(mx, __shfl_xor(mx, 16)); mx = fmaxf(mx, __shfl_xor(mx, 32));
        float l = 0.f;
#pragma unroll
        for (int kbi = 0; kbi < 9; ++kbi)
#pragma unroll
            for (int j = 0; j < 4; ++j) { const float pv = (sacc[kbi][j] > -1.0e38f) ? __expf(sacc[kbi][j] - mx) : 0.f; sacc[kbi][j] = pv; l += pv; }
        l += __shfl_xor(l, 16); l += __shfl_xor(l, 32);
        if (g4 == 0) LSE[((size_t)g * T + qtok) * 8 + hh] = mx + __logf(l);
        bf16x8 pb[5];
#pragma unroll
        for (int s5 = 0; s5 < 5; ++s5) { u32x4 t;
            t.x = pk2(sacc[2 * s5][0], sacc[2 * s5][1]); t.y = pk2(sacc[2 * s5][2], sacc[2 * s5][3]);
            if (s5 < 4) { t.z = pk2(sacc[2 * s5 + 1][0], sacc[2 * s5 + 1][1]); t.w = pk2(sacc[2 * s5 + 1][2], sacc[2 * s5 + 1][3]); } else { t.z = 0u; t.w = 0u; }
            pb[s5] = __builtin_bit_cast(bf16x8, t); }
        const float rl = 1.f / l;
        const unsigned q_ = fr >> 2, p_ = fr & 3;
        bf16_t* orow = QKVG + qtok * 10240 + qcol + 4 * g4;
#pragma unroll
        for (int c = 0; c < 8; ++c) {
            const unsigned vbase = (unsigned)(size_t)Vt + 256u * (16u * w + 4u * g4 + q_) + 16u * ((2u * c + (p_ >> 1)) ^ ((q_ << 2) | (unsigned)g4)) + 8u * (p_ & 1);
            u32x2 t0, t1, t2, t3, t4, t5, t6, t7, t8;
            asm volatile("ds_read_b64_tr_b16 %0, %9 offset:0\n\tds_read_b64_tr_b16 %1, %9 offset:4096\n\tds_read_b64_tr_b16 %2, %9 offset:8192\n\t"
                         "ds_read_b64_tr_b16 %3, %9 offset:12288\n\tds_read_b64_tr_b16 %4, %9 offset:16384\n\tds_read_b64_tr_b16 %5, %9 offset:20480\n\t"
                         "ds_read_b64_tr_b16 %6, %9 offset:24576\n\tds_read_b64_tr_b16 %7, %9 offset:28672\n\tds_read_b64_tr_b16 %8, %9 offset:32768\n\t"
                         "s_waitcnt lgkmcnt(0)"
                         : "=&v"(t0), "=&v"(t1), "=&v"(t2), "=&v"(t3), "=&v"(t4), "=&v"(t5), "=&v"(t6), "=&v"(t7), "=&v"(t8) : "v"(vbase) : "memory");
            f32x4 oacc = (f32x4){0.f, 0.f, 0.f, 0.f};
            oacc = __builtin_amdgcn_mfma_f32_16x16x32_bf16(__builtin_bit_cast(bf16x8, (u32x4){t0.x, t0.y, t1.x, t1.y}), pb[0], oacc, 0, 0, 0);
            oacc = __builtin_amdgcn_mfma_f32_16x16x32_bf16(__builtin_bit_cast(bf16x8, (u32x4){t2.x, t2.y, t3.x, t3.y}), pb[1], oacc, 0, 0, 0);
            oacc = __builtin_amdgcn_mfma_f32_16x16x32_bf16(__builtin_bit_cast(bf16x8, (u32x4){t4.x, t4.y, t5.x, t5.y}), pb[2], oacc, 0, 0, 0);
            oacc = __builtin_amdgcn_mfma_f32_16x16x32_bf16(__builtin_bit_cast(bf16x8, (u32x4){t6.x, t6.y, t7.x, t7.y}), pb[3], oacc, 0, 0, 0);
            oacc = __builtin_amdgcn_mfma_f32_16x16x32_bf16(__builtin_bit_cast(bf16x8, (u32x4){t8.x, t8.y, t8.x, t8.y}), pb[4], oacc, 0, 0, 0);
            u32x2 o; o.x = pk2(oacc[0] * rl, oacc[1] * rl); o.y = pk2(oacc[2] * rl, oacc[3] * rl);
            *(u32x2*)(orow + 16 * c) = o;
        }
    }
}
__device__ __forceinline__ void attn_combine_phase(int tid, const bf16_t* QKVG, const float* LSE, bf16_t* Z) {
    const long gt = (long)blockIdx.x * NTHR + tid, GT = (long)gridDim.x * NTHR;
    for (long i = gt; i < (long)T * 128; i += GT) {
        const size_t t = (size_t)(i >> 7); const int hh = (int)((i >> 4) & 7), d8 = (int)(i & 15);
        const float l0 = LSE[((size_t)0 * T + t) * 8 + hh], l1 = LSE[((size_t)1 * T + t) * 8 + hh], l2 = LSE[((size_t)2 * T + t) * 8 + hh];
        const float mx = fmaxf(l0, fmaxf(l1, l2)); float w0 = __expf(l0 - mx), w1 = __expf(l1 - mx), w2 = __expf(l2 - mx); const float rs = 1.f / (w0 + w1 + w2); w0 *= rs; w1 *= rs; w2 *= rs;
        const bf16_t* row = QKVG + t * 10240 + hh * 128 + d8 * 8;
        const u32x4 o0 = *(const u32x4*)row, o1 = *(const u32x4*)(row + 1024), o2 = *(const u32x4*)(row + 2048), gg = *(const u32x4*)(row + 9216);
        const unsigned a0[4] = {o0.x, o0.y, o0.z, o0.w}, a1[4] = {o1.x, o1.y, o1.z, o1.w}, a2[4] = {o2.x, o2.y, o2.z, o2.w}, ga[4] = {gg.x, gg.y, gg.z, gg.w}; unsigned ow[4];
#pragma unroll
        for (int j = 0; j < 4; ++j) {
            const float lo = (w0 * bf_lo(a0[j]) + w1 * bf_lo(a1[j]) + w2 * bf_lo(a2[j])) * siluf_(bf_lo(ga[j]));
            const float hi = (w0 * bf_hi(a0[j]) + w1 * bf_hi(a1[j]) + w2 * bf_hi(a2[j])) * siluf_(bf_hi(ga[j]));
            ow[j] = pk2(lo, hi); }
        *(u32x4*)(Z + t * 1024 + hh * 128 + d8 * 8) = (u32x4){ow[0], ow[1], ow[2], ow[3]};
    }
}
__device__ __forceinline__ void pool_diff_phase(int tid, const bf16_t* UG, bf16_t* DIFF) {
    const long gt = (long)blockIdx.x * NTHR + tid, GT = (long)gridDim.x * NTHR;
    for (long i = gt; i < (long)NB * 32 * 256; i += GT) {
        const int c8 = (int)(i & 255), chunk = (int)((i >> 8) & 31), b = (int)(i >> 13);
        const int win = 2 << (c8 >> 6); const float rwin = 1.f / (float)win;
        const int t0 = chunk * 64;
        const bf16_t* ub = UG + (size_t)b * SEQ * 4096 + c8 * 8;
        float sum[8];
#pragma unroll
        for (int j = 0; j < 8; ++j) sum[j] = 0.f;
        for (int s = t0 - win + 1; s < t0; ++s) if (s >= 0) { const u32x4 v = *(const u32x4*)(ub + (size_t)s * 4096); const unsigned vw[4] = {v.x, v.y, v.z, v.w};
#pragma unroll
            for (int j = 0; j < 4; ++j) { sum[2 * j] += bf_lo(vw[j]); sum[2 * j + 1] += bf_hi(vw[j]); } }
        for (int t = t0; t < t0 + 64; ++t) {
            const u32x4 v = *(const u32x4*)(ub + (size_t)t * 4096); const unsigned vw[4] = {v.x, v.y, v.z, v.w};
            float u[8];
#pragma unroll
            for (int j = 0; j < 4; ++j) { u[2 * j] = bf_lo(vw[j]); u[2 * j + 1] = bf_hi(vw[j]); sum[2 * j] += u[2 * j]; sum[2 * j + 1] += u[2 * j + 1]; }
            const float rc = (t + 1 < win) ? 1.f / (float)(t + 1) : rwin;
            u32x4 o; o.x = pk2(sum[0] * rc - u[0], sum[1] * rc - u[1]); o.y = pk2(sum[2] * rc - u[2], sum[3] * rc - u[3]);
            o.z = pk2(sum[4] * rc - u[4], sum[5] * rc - u[5]); o.w = pk2(sum[6] * rc - u[6], sum[7] * rc - u[7]);
            *(u32x4*)(DIFF + ((size_t)b * SEQ + t) * Dm + c8 * 8) = o;
            if (t - win + 1 >= 0) { const u32x4 q = *(const u32x4*)(ub + (size_t)(t - win + 1) * 4096); const unsigned qw[4] = {q.x, q.y, q.z, q.w};
#pragma unroll
                for (int j = 0; j < 4; ++j) { sum[2 * j] -= bf_lo(qw[j]); sum[2 * j + 1] -= bf_hi(qw[j]); } }
        }
    }
}

#define XB_TMO      128
#define XB_XCNT(j)  (256  + 64 * (j))
#define XB_XSUB(j)  (1280 + 64 * (j))
#define XB_XGEN(j)  (2304 + 64 * (j))
#define XB_TOP      3328
#define XB_TOPGEN   3392
#define XCD_BAR_WORDS 3456
#define XB_SPIN_CAP (1u << 20)
__device__ __forceinline__ unsigned xb_ld(unsigned* p)              { return __hip_atomic_load(p, __ATOMIC_RELAXED, __HIP_MEMORY_SCOPE_AGENT); }
__device__ __forceinline__ unsigned xb_add(unsigned* p, unsigned v) { return __hip_atomic_fetch_add(p, v, __ATOMIC_RELAXED, __HIP_MEMORY_SCOPE_AGENT); }
__device__ __forceinline__ unsigned xb_xcc_id() { return (unsigned)__builtin_amdgcn_s_getreg((3 << 11) | 20) & 0xFu; }
#define XB_SPIN(cond, bar) do { unsigned _sp = 0; while (cond) { __builtin_amdgcn_s_sleep(1); \
    if ((++_sp & 255u) == 0u) { if (xb_ld(&(bar)[XB_TMO])) break; if (_sp > XB_SPIN_CAP) { atomicAdd(&(bar)[XB_TMO], 1u); break; } } } } while (0)
struct XcdBarrier { unsigned* bar; unsigned x; volatile LAS unsigned* st; };
__device__ __forceinline__ XcdBarrier xcd_barrier_post(unsigned* bar, volatile LAS unsigned* st) {
    XcdBarrier b; b.bar = bar; b.x = xb_xcc_id(); b.st = st;
    if (threadIdx.x == 0) (void)xb_add(&bar[XB_XCNT(b.x)], 1u);
    return b;
}
__device__ __forceinline__ void xcd_barrier_complete(unsigned* bar, unsigned x, unsigned& nloc, unsigned& nx) {
    const unsigned G = gridDim.x * gridDim.y * gridDim.z;
    unsigned sum, cnt, mine, sp = 0u;
    for (;;) {
        sum = 0u; cnt = 0u; mine = 0u;
#pragma unroll
        for (unsigned j = 0; j < 16; ++j) { const unsigned c = xb_ld(&bar[XB_XCNT(j)]); sum += c; cnt += (c > 0u) ? 1u : 0u; mine = (j == x) ? c : mine; }
        if (sum == G) break;
        __builtin_amdgcn_s_sleep(1);
        if ((++sp & 255u) == 0u) { if (xb_ld(&bar[XB_TMO])) break; if (sp > XB_SPIN_CAP) { atomicAdd(&bar[XB_TMO], 1u); break; } }
    }
    nloc = mine > 0u ? mine : 1u; nx = cnt > 0u ? cnt : 1u;
}
__device__ __forceinline__ void xcd_barrier(const XcdBarrier& b) {
    asm volatile("s_waitcnt vmcnt(0)" ::: "memory");
    __syncthreads();
    if (threadIdx.x == 0) {
        unsigned* bar = b.bar;
        __builtin_amdgcn_s_waitcnt(0);
        unsigned nloc = b.st[0], nx = b.st[1];
        if (nloc == 0u) { xcd_barrier_complete(bar, b.x, nloc, nx); b.st[0] = nloc; b.st[1] = nx; }
        const unsigned old = xb_add(&bar[XB_XSUB(b.x)], 1u);
        const unsigned gen = old / nloc;
        if (old + 1u == (gen + 1u) * nloc) {
            __builtin_amdgcn_fence(__ATOMIC_RELEASE, "agent");
            asm volatile("s_waitcnt vmcnt(0)" ::: "memory");
            const unsigned og = xb_add(&bar[XB_TOP], 1u);
            const unsigned tg = og / nx;
            if (og + 1u == (tg + 1u) * nx) xb_add(&bar[XB_TOPGEN], 1u);
            else XB_SPIN(xb_ld(&bar[XB_TOPGEN]) == tg, bar);
            __builtin_amdgcn_fence(__ATOMIC_ACQUIRE, "agent");
            xb_add(&bar[XB_XGEN(b.x)], 1u);
            asm volatile("s_waitcnt vmcnt(0)" ::: "memory");
        } else {
            XB_SPIN(xb_ld(&bar[XB_XGEN(b.x)]) == gen, bar);
            __builtin_amdgcn_fence(__ATOMIC_ACQUIRE, "agent");
            asm volatile("s_waitcnt vmcnt(0)" ::: "memory");
        }
    }
    __syncthreads();
}

__global__ void __launch_bounds__(NTHR) mega_fwd(Params p) {
    extern __shared__ __attribute__((aligned(16))) unsigned char lds_raw[];
    LAS unsigned char* lds = (LAS unsigned char*)lds_raw;
    cg::grid_group grid = cg::this_grid();
    const int ph_lo = p.ph_lo, ph_hi = p.ph_hi;
    volatile LAS unsigned* xst = (volatile LAS unsigned*)(lds + LDS_BYTES);
    if (threadIdx.x == 0) { xst[0] = 0u; xst[1] = 0u; }
    __syncthreads();
    const XcdBarrier xb = xcd_barrier_post((unsigned*)(p.ws + WS_BAR), xst);
    bool first_sync = true;
    int ph = 0;
#define RUN(ty, ...) do { if (ph >= ph_lo && ph < ph_hi) { { int tid = threadIdx.x; asm volatile("" : "+v"(tid)); __VA_ARGS__; } \
        if (ph + 1 < ph_hi) { if (first_sync) { grid.sync(); first_sync = false; } else xcd_barrier(xb); } } ++ph; } while (0)
    unsigned char* ws = p.ws;
    bf16_t* Wt = (bf16_t*)(ws + WS_W);
    bf16_t* LORA = (bf16_t*)(ws + WS_LORA);
    bf16_t* VF = (bf16_t*)(ws + WS_VF); bf16_t* B1 = (bf16_t*)(ws + WS_B1); bf16_t* B2 = (bf16_t*)(ws + WS_B2); bf16_t* B3 = (bf16_t*)(ws + WS_B3);
    bf16_t* B4 = (bf16_t*)(ws + WS_B4); bf16_t* M0 = (bf16_t*)(ws + WS_M0); bf16_t* M1 = (bf16_t*)(ws + WS_M1);
    for (int L = 0; L < 4; ++L) {
        const int kind = L % 3;
        bf16_t* XSA = (bf16_t*)p.out; bf16_t* XSB = XSA + (size_t)T * Dm;
        const void* xin = (L == 0) ? (const void*)p.in[0] : (L == 1) ? (const void*)XSA : (L == 2) ? (const void*)XSB : (const void*)M1;
        const float* nw = p.in[2] + (size_t)L * Dm;
        const bf16_t* oA; const bf16_t* oB; int olda, ont;
        if (kind == 0) {
            const int ia = L / 3; const bool has_v = ia > 0;
            const float* mu = p.in[3] + (size_t)ia * 6 * Dm;
            bf16_t* Vb = has_v ? B3 : VF;
            for (int rd = 0; rd < 2; ++rd) {
                RUN(0, if (rd == 0) rwkv_weights(tid, p, ia, has_v, lds);
                    if (L == 0) norm_mix_phase<3, false>(tid, xin, nw, mu + (size_t)(3 * rd) * Dm, mu + (size_t)(3 * rd + 1) * Dm, M0, XSA, mu + (size_t)(3 * rd + 2) * Dm, XSB);
                    else norm_mix_phase<3, true>(tid, xin, nw, mu + (size_t)(3 * rd) * Dm, mu + (size_t)(3 * rd + 1) * Dm, M0, XSA, mu + (size_t)(3 * rd + 2) * Dm, XSB));
                RUN(1, ProbRwkvIn pr; pr.nM = T / BM; pr.nN = (rd == 0) ? (has_v ? 25 : 24) : 10; pr.nt = Dm / BK; pr.lda = Dm; pr.ldb = Dm; pr.round = rd;
                    pr.A0 = M0; pr.dA1 = (long)(((const char*)XSA - (const char*)M0) / 2); pr.dA2 = (long)(((const char*)XSB - (const char*)M0) / 2); pr.Wt = Wt;
                    pr.O0 = B1; pr.dO1 = B2 - B1; pr.dO2 = Vb - B1; pr.dO3 = B4 - B1; pr.lora = LORA; gemm_phase(tid, lds, pr));
            }
            RUN(2, ProbRwkvUp pu; pu.nM = T / BM; pu.nN = has_v ? 24 : 16; pu.nt = 4; pu.lda = 256; pu.ldb = 256; pu.A = LORA; pu.Bt = Wt + (size_t)11008 * 2048;
                pu.w0 = p.in[5] + (size_t)ia * Dm; pu.d_a0 = (long)((p.in[8] + (size_t)ia * Dm) - pu.w0); pu.d_v0 = (long)(p.in[16] - pu.w0); pu.E = M0; pu.AL = XSA; pu.V = B3; pu.VF = VF; gemm_phase(tid, lds, pu));
            RUN(3, scan_phase(tid, lds, B1, M0, B2, Vb, XSA, B4, p.in[11] + (size_t)ia * Dm, p.in[12] + (size_t)ia * Dm, p.in[13] + (size_t)ia * Dm, p.in[14] + (size_t)ia * Dm, p.in[15] + (size_t)ia * Dm, B1));
            oA = B1; oB = Wt + (size_t)8192 * 2048; olda = Dm; ont = Dm / BK;
        } else {
            RUN(4, if (kind == 1) attn_weights(tid, p, lds); else pool_weights(tid, p, lds); norm_mix_phase<0, true>(tid, xin, nw, nullptr, nullptr, M1, nullptr));
            RUN(5, ProbStoreBf16 ps; ps.nM = T / BM; ps.nN = (kind == 1) ? 40 : 16; ps.nt = Dm / BK; ps.lda = Dm; ps.ldb = Dm; ps.A = M1; ps.Bt = Wt; ps.O = B1; ps.ldo = (kind == 1) ? 10240 : 4096; gemm_phase(tid, lds, ps));
            if (kind == 1) {
                RUN(7, attn_phase(tid, lds, B1, (float*)(ws + WS_LSE), p.in[21], p.in[22], (const float*)(ws + WS_COS), (const float*)(ws + WS_SIN)));
                RUN(8, attn_combine_phase(tid, B1, (const float*)(ws + WS_LSE), M1));
                oA = M1; oB = Wt + (size_t)10240 * 2048; olda = 1024; ont = 1024 / BK;
            } else {
                RUN(9, pool_diff_phase(tid, B1, B3));
                RUN(10, ProbPoolGrp pg; pg.nM = T / BM; pg.nN = 8; pg.nt = 512 / BK; pg.lda = Dm; pg.ldb = 512; pg.A = B3; pg.Bt = Wt + (size_t)4096 * 2048; pg.scale = p.in[26]; pg.UG = B1; pg.Z = B4; gemm_phase(tid, lds, pg));
                oA = B4; oB = Wt + (size_t)4096 * 2048 + (size_t)2048 * 512; olda = Dm; ont = Dm / BK;
            }
        }
        RUN(11, ProbResid po; po.nM = T / BM; po.nN = 8; po.nt = ont; po.lda = olda; po.ldb = olda; po.A = oA; po.Bt = oB; po.xin = xin; po.in_bf = (L != 0); po.xout = (L == 0) ? (void*)XSA : (L == 1) ? (void*)XSB : (L == 2) ? (void*)M1 : (void*)p.out; po.out_bf = (L != 3); gemm_phase(tid, lds, po));
    }
#undef RUN
}
constexpr int N_PHASES = 7 + 5 + 5 + 7;

extern "C" void kernel_launch(void* const* d_in, const int* in_sizes, int n_in, void* d_out, int out_size, void* d_ws, size_t ws_size, hipStream_t stream) {
    static int grid = 0;
    if (grid == 0) {
        if (n_in != 28 || ws_size < WS_END) { fprintf(stderr, "kernel_launch: unexpected n_in %d / ws_size %zu\n", n_in, ws_size); grid = -1; return; }
        int dev = 0, cus = 0, per_cu = 0;
        hipGetDevice(&dev); hipDeviceGetAttribute(&cus, hipDeviceAttributeMultiprocessorCount, dev);
        if (hipFuncSetAttribute((const void*)mega_fwd, hipFuncAttributeMaxDynamicSharedMemorySize, LDS_BYTES + 64) != hipSuccess) { fprintf(stderr, "kernel_launch: hipFuncSetAttribute failed\n"); grid = -1; return; }
        if (hipOccupancyMaxActiveBlocksPerMultiprocessor(&per_cu, (const void*)mega_fwd, NTHR, LDS_BYTES + 64) != hipSuccess || per_cu < 1) { fprintf(stderr, "kernel_launch: occupancy query failed (%d)\n", per_cu); per_cu = 1; }
        (void)hipGetLastError();
        grid = cus;
    }
    if (grid < 0) return;
    if (hipMemsetAsync((unsigned char*)d_ws + WS_BAR, 0, XCD_BAR_WORDS * 4, stream) != hipSuccess) { fprintf(stderr, "kernel_launch: memset failed\n"); return; }
    Params p{};
    for (int i = 0; i < 28; ++i) p.in[i] = (const float*)d_in[i];
    p.positions = (const int*)d_in[1]; p.out = (float*)d_out; p.ws = (unsigned char*)d_ws;
#if MK_MULTI
    for (int k = 0; k < N_PHASES; ++k) { p.ph_lo = k; p.ph_hi = k + 1; hipLaunchKernelGGL(mega_fwd, dim3(grid), dim3(NTHR), LDS_BYTES + 64, stream, p); }
#else
    p.ph_lo = 0; p.ph_hi = N_PHASES;
    void* args[] = {&p};
    hipError_t e = hipLaunchCooperativeKernel((const void*)mega_fwd, dim3(grid), dim3(NTHR), args, LDS_BYTES + 64, stream);
    if (e != hipSuccess) fprintf(stderr, "cooperative launch failed: %s (grid %d)\n", hipGetErrorString(e), grid);
#endif
}
```

```cpp
#include <hip/hip_runtime.h>
#include <hip/hip_cooperative_groups.h>
#include <cstdio>
namespace cg = cooperative_groups;

#ifndef MK_MULTI
#define MK_MULTI 0
#endif

#define LAS __attribute__((address_space(3)))
typedef unsigned short bf16_t;
typedef short bf16x8 __attribute__((ext_vector_type(8)));
typedef float f32x4 __attribute__((ext_vector_type(4)));
typedef float f32x2 __attribute__((ext_vector_type(2)));
typedef unsigned u32x4 __attribute__((ext_vector_type(4)));
typedef unsigned u32x2 __attribute__((ext_vector_type(2)));
typedef unsigned short u16x4 __attribute__((ext_vector_type(4)));

constexpr int Dm = 2048, NB = 16, SEQ = 2048, T = NB * SEQ;
constexpr float RMS_EPS = 1e-6f, LN_EPS = 64e-5f;
constexpr int NTHR = 512, NWAVE = 8;
constexpr int LDS_BYTES = 128 * 1024;
constexpr size_t MiB = 1024 * 1024;
constexpr size_t WS_W = 0;
constexpr size_t WS_LORA = 64 * MiB;
constexpr size_t WS_COS = 80 * MiB;
constexpr size_t WS_SIN = 82 * MiB;
constexpr size_t WS_LSE = 84 * MiB;
constexpr size_t WS_BAR = 88 * MiB;
constexpr size_t WS_VF = 128 * MiB;
constexpr size_t WS_B1 = 256 * MiB, WS_B2 = 384 * MiB, WS_B3 = 512 * MiB, WS_B4 = 640 * MiB, WS_M0 = 768 * MiB, WS_M1 = 896 * MiB;
constexpr size_t WS_END = 1024 * MiB;

struct Params {
    const float* in[28];
    const int* positions;
    float* out;
    unsigned char* ws;
    int ph_lo, ph_hi;
};

__device__ __forceinline__ unsigned pk2(float lo, float hi) { unsigned r; asm volatile("v_cvt_pk_bf16_f32 %0, %1, %2" : "=v"(r) : "v"(lo), "v"(hi)); return r; }
__device__ __forceinline__ float bf_lo(unsigned u) { return __uint_as_float(u << 16); }
__device__ __forceinline__ float bf_hi(unsigned u) { return __uint_as_float(u & 0xffff0000u); }
__device__ __forceinline__ unsigned pkh2(float lo, float hi) { typedef _Float16 h2 __attribute__((ext_vector_type(2))); h2 v; v.x = (_Float16)lo; v.y = (_Float16)hi; return __builtin_bit_cast(unsigned, v); }
__device__ __forceinline__ float h_lo(unsigned u) { typedef _Float16 h2 __attribute__((ext_vector_type(2))); h2 v = __builtin_bit_cast(h2, u); return (float)v.x; }
__device__ __forceinline__ float h_hi(unsigned u) { typedef _Float16 h2 __attribute__((ext_vector_type(2))); h2 v = __builtin_bit_cast(h2, u); return (float)v.y; }
__device__ __forceinline__ float wave_sum(float v) {
#pragma unroll
    for (int o = 1; o < 64; o <<= 1) v += __shfl_xor(v, o);
    return v;
}
__device__ __forceinline__ float quad_sum(float v) {
    v += __int_as_float(__builtin_amdgcn_update_dpp(0, __float_as_int(v), 0xB1, 0xF, 0xF, true));
    v += __int_as_float(__builtin_amdgcn_update_dpp(0, __float_as_int(v), 0x4E, 0xF, 0xF, true));
    return v;
}
__device__ __forceinline__ float row16_sum(float v) {
    v = quad_sum(v);
    v += __int_as_float(__builtin_amdgcn_update_dpp(0, __float_as_int(v), 0x124, 0xF, 0xF, true));
    v += __int_as_float(__builtin_amdgcn_update_dpp(0, __float_as_int(v), 0x128, 0xF, 0xF, true));
    return v;
}
__device__ __forceinline__ float sigmoidf_(float x) { return 1.f / (1.f + __expf(-x)); }
__device__ __forceinline__ float siluf_(float x) { return x / (1.f + __expf(-x)); }

constexpr int BM = 256, BK = 64, HALF = 128, HTB = HALF * BK * 2, NXCD = 8, WGM = 8;
__device__ __forceinline__ int lds_byte(int r, int c) { const int st = (r >> 4) * 2 + (c >> 5), rr = r & 15, cc = c & 31, ob = rr * 64 + cc * 2; return st * 1024 + (ob ^ (((ob >> 9) & 1) << 5)); }
__device__ __forceinline__ void stage_rc(int b, int& R, int& C) { const int st = b / 1024, sb = b % 1024, swz = sb ^ (((sb >> 9) & 1) << 5); R = (st >> 1) * 16 + swz / 64; C = (st & 1) * 32 + (swz % 64) / 2; }
__device__ __forceinline__ int perm32(int rho) { const int n = rho >> 4, i = rho & 15; return 8 * (i >> 2) + 4 * n + (i & 3); }
struct Unit { int pm, pn; };
__device__ __forceinline__ bool unit_next(int nM, int nN, int i, Unit& u) {
    const int nwg = nM * nN; const long L = (long)i * gridDim.x + blockIdx.x; if (L >= nwg) return false;
    int wgid = (int)L; { const int q = nwg / NXCD, r = nwg % NXCD, xcd = wgid % NXCD, off = wgid / NXCD; wgid = (xcd < r ? xcd * (q + 1) : r * (q + 1) + (xcd - r) * q) + off; }
    const int nig = WGM * nN, gid = wgid / nig, fm = gid * WGM, gsz = (nM - fm) < WGM ? (nM - fm) : WGM;
    u.pm = fm + ((wgid % nig) % gsz); u.pn = (wgid % nig) / gsz; return true;
}

template <class P>
__device__ __forceinline__ void gemm_phase(int tid, LAS unsigned char* lds, const P& prob) {
    const int wid = __builtin_amdgcn_readfirstlane(tid >> 6), lane = tid & 63, wr = wid >> 2, wc = wid & 3, fr = lane & 15, fq = lane >> 4;
    const int nt = prob.nt;
    unsigned voffA[2], voffB[2];
#pragma unroll
    for (int i = 0; i < 2; ++i) { int R, C; stage_rc(tid * 16 + i * 8192, R, C); const int Rb = P::PERM ? ((R & ~31) + perm32(R & 31)) : R;
        voffA[i] = (unsigned)(R * prob.lda + C) * 2u; voffB[i] = (unsigned)(Rb * prob.ldb + C) * 2u; }
    const size_t kstep = (size_t)(BK * 2);
    const size_t hstepA = (size_t)HALF * prob.lda * 2, hstepB = (size_t)HALF * prob.ldb * 2;
    const unsigned ldsw = (unsigned)wid * 1024u;
    const int aoff = lds_byte(wr * 64 + fr, fq * 8), boff = lds_byte(wc * 32 + fr, fq * 8);
#define G_SA(b, h) (((b) * 2 + (h)) * HTB)
#define G_SB(b, h) ((4 + (b) * 2 + (h)) * HTB)
#define G_STAGE(bufoff, gbase, voff) do { _Pragma("unroll") for (int _i = 0; _i < 2; ++_i) \
        __builtin_amdgcn_global_load_lds((const unsigned*)((const char*)(gbase) + (voff)[_i]), (LAS unsigned*)(lds + (bufoff) + ldsw + _i * 8192), 16, 0, 0); } while (0)
#define G_LDA(dst, b, h) do { _Pragma("unroll") for (int m = 0; m < 4; ++m) _Pragma("unroll") for (int k = 0; k < 2; ++k) dst[m][k] = *(const LAS bf16x8*)(lds + G_SA(b, h) + aoff + m * 2048 + k * 1024); } while (0)
#define G_LDB(dst, b, h) do { _Pragma("unroll") for (int n = 0; n < 2; ++n) _Pragma("unroll") for (int k = 0; k < 2; ++k) dst[n][k] = *(const LAS bf16x8*)(lds + G_SB(b, h) + boff + n * 2048 + k * 1024); } while (0)
#define G_MMA(ai, bj, At, Bt) do { __builtin_amdgcn_s_setprio(1); _Pragma("unroll") for (int m = 0; m < 4; ++m) _Pragma("unroll") for (int n = 0; n < 2; ++n) _Pragma("unroll") for (int k = 0; k < 2; ++k) \
        acc[ai][bj][m][n] = __builtin_amdgcn_mfma_f32_16x16x32_bf16(Bt[n][k], At[m][k], acc[ai][bj][m][n], 0, 0, 0); __builtin_amdgcn_s_setprio(0); } while (0)
#define G_WAIT_V(n) asm volatile("s_waitcnt vmcnt(" #n ")" ::: "memory")
#define G_WAIT_L(n) asm volatile("s_waitcnt lgkmcnt(" #n ")" ::: "memory")
#define G_BAR __builtin_amdgcn_s_barrier()
#define G_SCHED __builtin_amdgcn_sched_barrier(0)
    Unit cur, nxt; int ui = 0;
    if (!unit_next(prob.nM, prob.nN, 0, cur)) return;
    f32x4 acc[2][2][4][2];
    prob.init_acc(acc, cur, wr, wc, fr, fq);
    bf16x8 At[4][2], B0[2][2], B1[2][2];
    const char* cA = prob.a_ptr(cur); const char* cB = prob.b_ptr(cur);
    G_STAGE(G_SB(0, 0), cB, voffB); G_STAGE(G_SA(0, 0), cA, voffA); G_STAGE(G_SB(0, 1), cB + hstepB, voffB); G_STAGE(G_SA(0, 1), cA + hstepA, voffA);
    if (wr == 1) G_BAR;
    G_WAIT_V(4); G_BAR;
    G_STAGE(G_SB(1, 0), cB + kstep, voffB); G_STAGE(G_SA(1, 0), cA + kstep, voffA); G_STAGE(G_SB(1, 1), cB + hstepB + kstep, voffB);
    G_WAIT_V(6); G_BAR;
    for (;;) {
        const bool has_next = unit_next(prob.nM, prob.nN, ui + 1, nxt);
        const char* nA = has_next ? prob.a_ptr(nxt) : cA; const char* nB = has_next ? prob.b_ptr(nxt) : cB;
        for (int t = 0; t < nt; t += 2) {
            const bool last = (t == nt - 2);
            const char* a1 = cA + (size_t)(t + 1) * kstep;
            const char* a2 = last ? nA : cA + (size_t)(t + 2) * kstep; const char* b2 = last ? nB : cB + (size_t)(t + 2) * kstep;
            const char* a3 = a2 + kstep; const char* b3 = b2 + kstep;
            G_LDB(B0, 0, 0); G_SCHED; G_LDA(At, 0, 0); G_STAGE(G_SA(1, 1), a1 + hstepA, voffA);
            G_WAIT_L(8); G_BAR; G_WAIT_L(0); G_MMA(0, 0, At, B0); G_BAR; G_SCHED;
            G_LDB(B1, 0, 1); G_STAGE(G_SB(0, 0), b2, voffB);
            G_BAR; G_WAIT_L(0); G_MMA(0, 1, At, B1); G_BAR;
            G_LDA(At, 0, 1); G_STAGE(G_SA(0, 0), a2, voffA);
            G_BAR; G_WAIT_L(0); G_MMA(1, 0, At, B0); G_BAR; G_SCHED;
            G_STAGE(G_SB(0, 1), b2 + hstepB, voffB);
            G_WAIT_V(6); G_BAR; G_MMA(1, 1, At, B1); G_BAR;
            G_LDB(B0, 1, 0); G_SCHED; G_LDA(At, 1, 0); G_STAGE(G_SA(0, 1), a2 + hstepA, voffA);
            G_WAIT_L(8); G_BAR; G_WAIT_L(0); G_MMA(0, 0, At, B0); G_BAR; G_SCHED;
            G_LDB(B1, 1, 1); G_STAGE(G_SB(1, 0), b3, voffB);
            G_BAR; G_WAIT_L(0); G_MMA(0, 1, At, B1); G_BAR;
            G_LDA(At, 1, 1); G_STAGE(G_SA(1, 0), a3, voffA);
            G_BAR; G_WAIT_L(0); G_MMA(1, 0, At, B0); G_BAR; G_SCHED;
            G_STAGE(G_SB(1, 1), b3 + hstepB, voffB);
            G_WAIT_V(6); G_BAR; G_MMA(1, 1, At, B1); G_BAR;
        }
        prob.epi(acc, cur, wr, wc, fr, fq);
        if (!has_next) break;
        prob.init_acc(acc, nxt, wr, wc, fr, fq);
        cur = nxt; cA = nA; cB = nB; ++ui;
    }
    G_WAIT_V(0);
    if (wr == 0) G_BAR;
    G_BAR;
#undef G_SA
#undef G_SB
#undef G_STAGE
#undef G_LDA
#undef G_LDB
#undef G_MMA
#undef G_WAIT_V
#undef G_WAIT_L
#undef G_BAR
#undef G_SCHED
}

#define EPI_ROWS(u) const int row0 = (u).pm * BM + wr * 64 + fr
#define EPI_FOR_RM _Pragma("unroll") for (int ai = 0; ai < 2; ++ai) _Pragma("unroll") for (int m = 0; m < 4; ++m)

#define PK8(v0, v1) ((u32x4){pk2((v0)[0], (v0)[1]), pk2((v0)[2], (v0)[3]), pk2((v1)[0], (v1)[1]), pk2((v1)[2], (v1)[3])})
struct ProbStoreBf16 {
    static constexpr bool PERM = true;
    int nM, nN, nt, lda, ldb;
    const bf16_t* A; const bf16_t* Bt; bf16_t* O; int ldo;
    __device__ __forceinline__ void init_acc(f32x4 (&acc)[2][2][4][2], const Unit&, int, int, int, int) const {
#pragma unroll
        for (int a = 0; a < 2; ++a)
#pragma unroll
            for (int b = 0; b < 2; ++b)
#pragma unroll
                for (int m = 0; m < 4; ++m)
#pragma unroll
                    for (int n = 0; n < 2; ++n) acc[a][b][m][n] = (f32x4){0.f, 0.f, 0.f, 0.f};
    }
    __device__ __forceinline__ const char* a_ptr(const Unit& u) const { return (const char*)(A + (size_t)u.pm * BM * lda); }
    __device__ __forceinline__ const char* b_ptr(const Unit& u) const { return (const char*)(Bt + (size_t)u.pn * BM * ldb); }
    __device__ __forceinline__ void epi(const f32x4 (&acc)[2][2][4][2], const Unit& u, int wr, int wc, int fr, int fq) const {
        EPI_ROWS(u); const int col0 = u.pn * BM + wc * 32 + 8 * fq;
        EPI_FOR_RM { bf16_t* rowp = O + (size_t)(row0 + ai * HALF + m * 16) * ldo + col0;
#pragma unroll
            for (int bj = 0; bj < 2; ++bj) { const f32x4 v0 = acc[ai][bj][m][0], v1 = acc[ai][bj][m][1];
                u32x4 o; o.x = pk2(v0[0], v0[1]); o.y = pk2(v0[2], v0[3]); o.z = pk2(v1[0], v1[1]); o.w = pk2(v1[2], v1[3]);
                *(u32x4*)(rowp + bj * HALF) = o; } }
    }
};
struct ProbResid {
    static constexpr bool PERM = true;
    int nM, nN, nt, lda, ldb;
    const bf16_t* A; const bf16_t* Bt; const void* xin; void* xout; int in_bf, out_bf;
    __device__ __forceinline__ void init_acc(f32x4 (&acc)[2][2][4][2], const Unit& u, int wr, int wc, int fr, int fq) const {
        EPI_ROWS(u); const int col0 = u.pn * BM + wc * 32 + 8 * fq;
        if (in_bf) {
#pragma unroll
            for (int ai = 0; ai < 2; ++ai)
#pragma unroll
                for (int bj = 0; bj < 2; ++bj)
#pragma unroll
                    for (int m = 0; m < 4; ++m) { const u32x4 r = *(const u32x4*)((const bf16_t*)xin + (size_t)(row0 + ai * HALF + m * 16) * Dm + col0 + bj * HALF);
                        acc[ai][bj][m][0] = (f32x4){bf_lo(r.x), bf_hi(r.x), bf_lo(r.y), bf_hi(r.y)}; acc[ai][bj][m][1] = (f32x4){bf_lo(r.z), bf_hi(r.z), bf_lo(r.w), bf_hi(r.w)}; }
        } else {
#pragma unroll
            for (int ai = 0; ai < 2; ++ai)
#pragma unroll
                for (int bj = 0; bj < 2; ++bj)
#pragma unroll
                    for (int m = 0; m < 4; ++m)
#pragma unroll
                        for (int n = 0; n < 2; ++n) acc[ai][bj][m][n] = *(const f32x4*)((const float*)xin + (size_t)(row0 + ai * HALF + m * 16) * Dm + col0 + bj * HALF + 4 * n);
        }
    }
    __device__ __forceinline__ const char* a_ptr(const Unit& u) const { return (const char*)(A + (size_t)u.pm * BM * lda); }
    __device__ __forceinline__ const char* b_ptr(const Unit& u) const { return (const char*)(Bt + (size_t)u.pn * BM * ldb); }
    __device__ __forceinline__ void epi(const f32x4 (&acc)[2][2][4][2], const Unit& u, int wr, int wc, int fr, int fq) const {
        EPI_ROWS(u); const int col0 = u.pn * BM + wc * 32 + 8 * fq;
        if (out_bf) {
            EPI_FOR_RM { const size_t ro = (size_t)(row0 + ai * HALF + m * 16) * Dm + col0;
#pragma unroll
                for (int bj = 0; bj < 2; ++bj) *(u32x4*)((bf16_t*)xout + ro + bj * HALF) = PK8(acc[ai][bj][m][0], acc[ai][bj][m][1]); }
        } else {
            EPI_FOR_RM { const size_t ro = (size_t)(row0 + ai * HALF + m * 16) * Dm + col0;
#pragma unroll
                for (int bj = 0; bj < 2; ++bj)
#pragma unroll
                    for (int n = 0; n < 2; ++n) *(f32x4*)((float*)xout + ro + bj * HALF + 4 * n) = acc[ai][bj][m][n]; }
        }
    }
};
struct ProbRwkvIn {
    static constexpr bool PERM = true;
    int nM, nN, nt, lda, ldb;
    int round;
    const bf16_t* A0; long dA1, dA2;
    const bf16_t* Wt;
    bf16_t* O0; long dO1, dO2, dO3; bf16_t* lora;
    __device__ __forceinline__ void init_acc(f32x4 (&acc)[2][2][4][2], const Unit&, int, int, int, int) const {
#pragma unroll
        for (int a = 0; a < 2; ++a)
#pragma unroll
            for (int b = 0; b < 2; ++b)
#pragma unroll
                for (int m = 0; m < 4; ++m)
#pragma unroll
                    for (int n = 0; n < 2; ++n) acc[a][b][m][n] = (f32x4){0.f, 0.f, 0.f, 0.f};
    }
    __device__ __forceinline__ int mixsel(const Unit& u) const { return (round == 0) ? ((u.pn == 24) ? 2 : (u.pn >> 3)) : ((u.pn < 8) ? 0 : (u.pn == 8) ? 1 : 2); }
    __device__ __forceinline__ bool is_lora(const Unit& u) const { return (round == 0) ? (u.pn == 24) : (u.pn >= 8); }
    __device__ __forceinline__ const char* a_ptr(const Unit& u) const {
        const int j = mixsel(u);
        return (const char*)(A0 + ((j == 1) ? dA1 : (j == 2) ? dA2 : 0L) + (size_t)u.pm * BM * lda); }
    __device__ __forceinline__ const char* b_ptr(const Unit& u) const {
        size_t rowoff;
        if (round == 0) rowoff = (u.pn == 24) ? (size_t)(10240 + 512) : (size_t)u.pn * BM;
        else rowoff = (u.pn < 8) ? (size_t)(6144 + u.pn * BM) : (size_t)(10240 + (u.pn - 8) * BM);
        return (const char*)(Wt + rowoff * 2048); }
    __device__ __forceinline__ void epi(const f32x4 (&acc)[2][2][4][2], const Unit& u, int wr, int wc, int fr, int fq) const {
        EPI_ROWS(u);
        if (is_lora(u)) {
            const int lim = (round == 0) ? 64 : 96, cb = (round == 0) ? 192 : (u.pn - 8) * 96; const bool th = (round == 1 && u.pn == 8);
            const int c = wc * 32 + 8 * fq;
            if (c < lim) {
                if (th) {
                    EPI_FOR_RM { bf16_t* rowp = lora + (size_t)(row0 + ai * HALF + m * 16) * 256 + cb + c; f32x4 a = acc[ai][0][m][0], b = acc[ai][0][m][1];
#pragma unroll
                        for (int j = 0; j < 4; ++j) { a[j] = 1.f - 2.f / (__expf(2.f * a[j]) + 1.f); b[j] = 1.f - 2.f / (__expf(2.f * b[j]) + 1.f); }
                        *(u32x4*)rowp = PK8(a, b); }
                } else {
                    EPI_FOR_RM { bf16_t* rowp = lora + (size_t)(row0 + ai * HALF + m * 16) * 256 + cb + c; const f32x4 a = acc[ai][0][m][0], b = acc[ai][0][m][1];
                        *(u32x4*)rowp = PK8(a, b); }
                }
            }
            return;
        }
        const int j = (round == 0) ? (u.pn >> 3) : 3;
        bf16_t* O = O0 + ((j == 1) ? dO1 : (j == 2) ? dO2 : (j == 3) ? dO3 : 0L); const int col0 = (u.pn & 7) * BM + wc * 32 + 8 * fq;
        EPI_FOR_RM { bf16_t* rowp = O + (size_t)(row0 + ai * HALF + m * 16) * Dm + col0;
#pragma unroll
            for (int bj = 0; bj < 2; ++bj) *(u32x4*)(rowp + bj * HALF) = PK8(acc[ai][bj][m][0], acc[ai][bj][m][1]); }
    }
};
struct ProbRwkvUp {
    static constexpr bool PERM = true;
    int nM, nN, nt, lda, ldb;
    const bf16_t* A; const bf16_t* Bt;
    const float* w0; long d_a0, d_v0;
    bf16_t* E; bf16_t* AL; bf16_t* SV;
    __device__ __forceinline__ void init_acc(f32x4 (&acc)[2][2][4][2], const Unit& u, int wr, int wc, int fr, int fq) const {
        const int kind = u.pn >> 3; const int col0 = (u.pn & 7) * BM + wc * 32 + 8 * fq;
        const float* bias = w0 + (kind == 1 ? d_a0 : kind == 2 ? d_v0 : 0L);
#pragma unroll
        for (int b = 0; b < 2; ++b)
#pragma unroll
            for (int n = 0; n < 2; ++n) { const f32x4 bvv = *(const f32x4*)(bias + col0 + b * HALF + 4 * n);
#pragma unroll
                for (int a = 0; a < 2; ++a)
#pragma unroll
                    for (int m = 0; m < 4; ++m) acc[a][b][m][n] = bvv; }
    }
    __device__ __forceinline__ const char* a_ptr(const Unit& u) const { return (const char*)(A + (size_t)u.pm * BM * lda); }
    __device__ __forceinline__ const char* b_ptr(const Unit& u) const { return (const char*)(Bt + (size_t)u.pn * BM * ldb); }
    __device__ __forceinline__ void epi(const f32x4 (&acc)[2][2][4][2], const Unit& u, int wr, int wc, int fr, int fq) const {
        EPI_ROWS(u); const int kind = u.pn >> 3; const int col0 = (u.pn & 7) * BM + wc * 32 + 8 * fq;
        if (kind == 0) {
            EPI_FOR_RM { const size_t ro = (size_t)(row0 + ai * HALF + m * 16) * Dm + col0;
#pragma unroll
                for (int bj = 0; bj < 2; ++bj) { f32x4 a = acc[ai][bj][m][0], b = acc[ai][bj][m][1];
#pragma unroll
                    for (int j = 0; j < 4; ++j) { a[j] = 0.6065306597126334f * sigmoidf_(a[j]); b[j] = 0.6065306597126334f * sigmoidf_(b[j]); }
                    u32x4 o; o.x = pkh2(a[0], a[1]); o.y = pkh2(a[2], a[3]); o.z = pkh2(b[0], b[1]); o.w = pkh2(b[2], b[3]);
                    *(u32x4*)(E + ro + bj * HALF) = o; } }
        } else if (kind == 1) {
            EPI_FOR_RM { const size_t ro = (size_t)(row0 + ai * HALF + m * 16) * Dm + col0;
#pragma unroll
                for (int bj = 0; bj < 2; ++bj) { f32x4 a = acc[ai][bj][m][0], b = acc[ai][bj][m][1];
#pragma unroll
                    for (int j = 0; j < 4; ++j) { a[j] = sigmoidf_(a[j]); b[j] = sigmoidf_(b[j]); }
                    u32x4 o; o.x = pkh2(a[0], a[1]); o.y = pkh2(a[2], a[3]); o.z = pkh2(b[0], b[1]); o.w = pkh2(b[2], b[3]);
                    *(u32x4*)(AL + ro + bj * HALF) = o; } }
        } else {
            EPI_FOR_RM { const size_t ro = (size_t)(row0 + ai * HALF + m * 16) * Dm + col0;
#pragma unroll
                for (int bj = 0; bj < 2; ++bj) { f32x4 a = acc[ai][bj][m][0], b = acc[ai][bj][m][1];
#pragma unroll
                    for (int j = 0; j < 4; ++j) { a[j] = sigmoidf_(a[j]); b[j] = sigmoidf_(b[j]); }
                    u32x4 o; o.x = pkh2(a[0], a[1]); o.y = pkh2(a[2], a[3]); o.z = pkh2(b[0], b[1]); o.w = pkh2(b[2], b[3]);
                    *(u32x4*)(SV + ro + bj * HALF) = o; } }
        }
    }
};
struct ProbPoolGrp {
    static constexpr bool PERM = true;
    int nM, nN, nt, lda, ldb;
    const bf16_t* A; const bf16_t* Bt; const float* scale; const bf16_t* UG; bf16_t* Z;
    __device__ __forceinline__ void init_acc(f32x4 (&acc)[2][2][4][2], const Unit&, int, int, int, int) const {
#pragma unroll
        for (int a = 0; a < 2; ++a)
#pragma unroll
            for (int b = 0; b < 2; ++b)
#pragma unroll
                for (int m = 0; m < 4; ++m)
#pragma unroll
                    for (int n = 0; n < 2; ++n) acc[a][b][m][n] = (f32x4){0.f, 0.f, 0.f, 0.f};
    }
    __device__ __forceinline__ const char* a_ptr(const Unit& u) const { return (const char*)(A + (size_t)u.pm * BM * lda + (u.pn >> 1) * 512); }
    __device__ __forceinline__ const char* b_ptr(const Unit& u) const { return (const char*)(Bt + (size_t)u.pn * BM * ldb); }
    __device__ __forceinline__ void epi(const f32x4 (&acc)[2][2][4][2], const Unit& u, int wr, int wc, int fr, int fq) const {
        EPI_ROWS(u); const int col0 = u.pn * BM + wc * 32 + 8 * fq;
        f32x4 sv[2][2];
#pragma unroll
        for (int bj = 0; bj < 2; ++bj) { sv[bj][0] = *(const f32x4*)(scale + col0 + bj * HALF); sv[bj][1] = *(const f32x4*)(scale + col0 + bj * HALF + 4); }
        EPI_FOR_RM { const size_t r = (size_t)(row0 + ai * HALF + m * 16);
#pragma unroll
            for (int bj = 0; bj < 2; ++bj) { const f32x4 v0 = acc[ai][bj][m][0] * sv[bj][0], v1 = acc[ai][bj][m][1] * sv[bj][1];
                const u32x4 gg = *(const u32x4*)(UG + r * 4096 + 2048 + col0 + bj * HALF);
                u32x4 o; o.x = pk2(v0[0] * siluf_(bf_lo(gg.x)), v0[1] * siluf_(bf_hi(gg.x))); o.y = pk2(v0[2] * siluf_(bf_lo(gg.y)), v0[3] * siluf_(bf_hi(gg.y)));
                o.z = pk2(v1[0] * siluf_(bf_lo(gg.z)), v1[1] * siluf_(bf_hi(gg.z))); o.w = pk2(v1[2] * siluf_(bf_lo(gg.w)), v1[3] * siluf_(bf_hi(gg.w)));
                *(u32x4*)(Z + r * Dm + col0 + bj * HALF) = o; } }
    }
};

__device__ __forceinline__ void transpose_item(const float* W, int sld, int N, bf16_t* WT, int dld, LAS float* scr, int item, int lane) {
    const int nblk = N / 32, kb = item / nblk, nb = item % nblk, k0 = 64 * kb, n0 = 32 * nb;
#pragma unroll 8
    for (int i = 0; i < 32; ++i) { const int kk = 2 * i + (lane >> 5); scr[kk * 33 + (lane & 31)] = W[(size_t)(k0 + kk) * sld + n0 + (lane & 31)]; }
    __builtin_amdgcn_fence(__ATOMIC_RELEASE, "wavefront"); __builtin_amdgcn_wave_barrier();
    const int c = lane & 7;
#pragma unroll
    for (int j = 0; j < 4; ++j) { const int n = (lane >> 3) + 8 * j; const LAS float* s = scr + (8 * c) * 33 + n;
        u32x4 o; o.x = pk2(s[0 * 33], s[1 * 33]); o.y = pk2(s[2 * 33], s[3 * 33]); o.z = pk2(s[4 * 33], s[5 * 33]); o.w = pk2(s[6 * 33], s[7 * 33]);
        *(u32x4*)(WT + (size_t)(n0 + n) * dld + k0 + 8 * c) = o; }
    __builtin_amdgcn_fence(__ATOMIC_RELEASE, "wavefront"); __builtin_amdgcn_wave_barrier();
}
struct TrJob { const float* W; int K, N, sld; bf16_t* WT; int dld; };
template <int NJ>
__device__ __forceinline__ void run_transposes(int tid, const TrJob (&jobs)[NJ], LAS unsigned char* lds) {
    const int wave = tid >> 6, lane = tid & 63, gw = blockIdx.x * NWAVE + wave, NGW = gridDim.x * NWAVE;
    LAS float* scr = (LAS float*)(lds + wave * 8448);
    int total = 0;
#pragma unroll
    for (int j = 0; j < NJ; ++j) total += (jobs[j].K / 64) * (jobs[j].N / 32);
    for (int it = gw; it < total; it += NGW) {
        int r = it;
#pragma unroll
        for (int j = 0; j < NJ; ++j) { const int cnt = (jobs[j].K / 64) * (jobs[j].N / 32);
            if (r >= 0 && r < cnt) transpose_item(jobs[j].W, jobs[j].sld, jobs[j].N, jobs[j].WT, jobs[j].dld, scr, r, lane);
            r -= cnt; }
    }
}

__device__ __forceinline__ void rwkv_weights(int tid, const Params& p, int ia, bool has_v, LAS unsigned char* lds) {
    bf16_t* Wt = (bf16_t*)(p.ws + WS_W);
    const float* win = p.in[4] + (size_t)ia * 4 * Dm * Dm;
    TrJob jobs[5];
#pragma unroll
    for (int j = 0; j < 4; ++j) jobs[j] = TrJob{win + (size_t)j * Dm * Dm, Dm, Dm, Dm, Wt + (size_t)j * Dm * Dm, Dm};
    jobs[4] = TrJob{p.in[19] + (size_t)ia * Dm * Dm, Dm, Dm, Dm, Wt + (size_t)8192 * 2048, Dm};
    run_transposes<5>(tid, jobs, lds);
    const float* w1 = p.in[6] + (size_t)ia * Dm * 96; const float* w2 = p.in[7] + (size_t)ia * 96 * Dm;
    const float* a1 = p.in[9] + (size_t)ia * Dm * 96; const float* a2 = p.in[10] + (size_t)ia * 96 * Dm;
    const float* v1 = p.in[17]; const float* v2 = p.in[18];
    bf16_t* Wd = Wt + (size_t)10240 * 2048; bf16_t* Wu = Wt + (size_t)11008 * 2048;
    const long gt = (long)blockIdx.x * NTHR + tid, GT = (long)gridDim.x * NTHR;
    const int ndt = has_v ? 3 : 2;
    for (long i = gt; i < (long)ndt * 256 * 256; i += GT) {
        const int n = (int)(i & 255), k8 = (int)((i >> 8) & 255), tile = (int)(i >> 16);
        const float* src = tile == 0 ? w1 : tile == 1 ? a1 : v1; const int rank = tile == 2 ? 64 : 96;
        float v[8];
#pragma unroll
        for (int j = 0; j < 8; ++j) v[j] = (n < rank) ? src[(size_t)(k8 * 8 + j) * rank + n] : 0.f;
        u32x4 o; o.x = pk2(v[0], v[1]); o.y = pk2(v[2], v[3]); o.z = pk2(v[4], v[5]); o.w = pk2(v[6], v[7]);
        *(u32x4*)(Wd + ((size_t)tile * 256 + n) * 2048 + k8 * 8) = o;
    }
    const int nup = has_v ? 6144 : 4096;
    for (long i = gt; i < (long)nup * 32; i += GT) {
        const int n = (int)(i % nup), k8 = (int)(i / nup), kind = n >> 11, nn = n & 2047;
        const float* src = kind == 0 ? w2 : kind == 1 ? a2 : v2; const int klo = kind * 96, rank = kind == 2 ? 64 : 96;
        float v[8];
#pragma unroll
        for (int j = 0; j < 8; ++j) { const int k = k8 * 8 + j - klo; v[j] = (k >= 0 && k < rank) ? src[(size_t)k * Dm + nn] : 0.f; }
        u32x4 o; o.x = pk2(v[0], v[1]); o.y = pk2(v[2], v[3]); o.z = pk2(v[4], v[5]); o.w = pk2(v[6], v[7]);
        *(u32x4*)(Wu + (size_t)n * 256 + k8 * 8) = o;
    }
}
template <bool XBF> __device__ __forceinline__ void ldrow8(const void* x, size_t t, int ck, f32x4& a, f32x4& b) {
    if (XBF) { const u32x4 r = __builtin_nontemporal_load((const u32x4*)((const bf16_t*)x + t * Dm) + ck);
        a = (f32x4){bf_lo(r.x), bf_hi(r.x), bf_lo(r.y), bf_hi(r.y)}; b = (f32x4){bf_lo(r.z), bf_hi(r.z), bf_lo(r.w), bf_hi(r.w)}; }
    else { const f32x4* p_ = (const f32x4*)((const float*)x + t * Dm) + 2 * ck; a = __builtin_nontemporal_load(p_); b = __builtin_nontemporal_load(p_ + 1); }
}
__device__ __forceinline__ float sq8(const f32x4& a, const f32x4& b) { return ((a.x * a.x + a.y * a.y) + (a.z * a.z + a.w * a.w)) + ((b.x * b.x + b.y * b.y) + (b.z * b.z + b.w * b.w)); }
template <int NMIX, bool XBF>
__device__ __forceinline__ void norm_mix_phase(int tid, const void* x, const float* nw, const float* mu0, const float* mu1, bf16_t* O0, bf16_t* O1, const float* mu2 = nullptr, bf16_t* O2 = nullptr) {
    const int wave = tid >> 6, lane = tid & 63, gw = blockIdx.x * NWAVE + wave, NGW = gridDim.x * NWAVE;
    for (int ch = gw; ch < T / 16; ch += NGW) {
        const int t0 = ch * 16;
        f32x4 hp[4][2];
        if (NMIX) {
            if ((t0 % SEQ) != 0) {
                float s = 0.f;
#pragma unroll
                for (int j = 0; j < 4; ++j) { ldrow8<XBF>(x, (size_t)(t0 - 1), lane + 64 * j, hp[j][0], hp[j][1]); s += sq8(hp[j][0], hp[j][1]); }
                const float rstd = rsqrtf(wave_sum(s) * (1.f / Dm) + RMS_EPS);
#pragma unroll
                for (int j = 0; j < 4; ++j) { hp[j][0] = hp[j][0] * rstd * ((const f32x4*)nw)[2 * (lane + 64 * j)]; hp[j][1] = hp[j][1] * rstd * ((const f32x4*)nw)[2 * (lane + 64 * j) + 1]; }
            } else {
#pragma unroll
                for (int j = 0; j < 4; ++j) { hp[j][0] = (f32x4){0.f, 0.f, 0.f, 0.f}; hp[j][1] = hp[j][0]; }
            }
        }
        f32x4 xn[4][2];
#pragma unroll
        for (int j = 0; j < 4; ++j) ldrow8<XBF>(x, (size_t)t0, lane + 64 * j, xn[j][0], xn[j][1]);
        for (int r = 0; r < 16; ++r) {
            const int t = t0 + r;
            f32x4 h[4][2]; float s = 0.f;
#pragma unroll
            for (int j = 0; j < 4; ++j) { h[j][0] = xn[j][0]; h[j][1] = xn[j][1]; s += sq8(h[j][0], h[j][1]); }
            if (r + 1 < 16) {
#pragma unroll
                for (int j = 0; j < 4; ++j) ldrow8<XBF>(x, (size_t)(t + 1), lane + 64 * j, xn[j][0], xn[j][1]); }
            const float rstd = rsqrtf(wave_sum(s) * (1.f / Dm) + RMS_EPS);
#pragma unroll
            for (int j = 0; j < 4; ++j) { h[j][0] = h[j][0] * rstd * ((const f32x4*)nw)[2 * (lane + 64 * j)]; h[j][1] = h[j][1] * rstd * ((const f32x4*)nw)[2 * (lane + 64 * j) + 1]; }
            if (NMIX) {
#pragma unroll
                for (int j = 0; j < 4; ++j) {
                    const int ck = lane + 64 * j;
                    const f32x4 d0 = hp[j][0] - h[j][0], d1 = hp[j][1] - h[j][1];
                    const f32x4 a0 = h[j][0] + d0 * ((const f32x4*)mu0)[2 * ck], a1 = h[j][1] + d1 * ((const f32x4*)mu0)[2 * ck + 1];
                    const f32x4 b0 = h[j][0] + d0 * ((const f32x4*)mu1)[2 * ck], b1 = h[j][1] + d1 * ((const f32x4*)mu1)[2 * ck + 1];
                    *((u32x4*)(O0 + (size_t)t * Dm) + ck) = PK8(a0, a1); *((u32x4*)(O1 + (size_t)t * Dm) + ck) = PK8(b0, b1);
                    if (NMIX == 3) { const f32x4 c0 = h[j][0] + d0 * ((const f32x4*)mu2)[2 * ck], c1 = h[j][1] + d1 * ((const f32x4*)mu2)[2 * ck + 1]; *((u32x4*)(O2 + (size_t)t * Dm) + ck) = PK8(c0, c1); }
                    hp[j][0] = h[j][0]; hp[j][1] = h[j][1];
                }
            } else {
#pragma unroll
                for (int j = 0; j < 4; ++j) *((u32x4*)(O0 + (size_t)t * Dm) + lane + 64 * j) = PK8(h[j][0], h[j][1]);
            }
        }
    }
}

constexpr int TC = 16, NCH = SEQ / TC;
constexpr int SC_OPS = 0, SC_VP = 2 * 5 * TC * 64 * 4, SC_BON = SC_VP + 3 * TC * 64 * 4, SC_YB = SC_BON + 3 * TC * 4 + 64, SC_PAIR = SC_YB + 2 * TC * 64 * 4;
static_assert(2 * SC_PAIR <= LDS_BYTES, "scan LDS");
struct ScanOps { f32x4 w[4], a[4], b[4], k[4], r[4]; f32x2 v; };
#define SC_PAIROF(arr, cp) (((cp) & 1) ? __builtin_shufflevector(arr[(cp) >> 1], arr[(cp) >> 1], 2, 3) : __builtin_shufflevector(arr[(cp) >> 1], arr[(cp) >> 1], 0, 1))
#define SC_LOAD(O, s_) do { _Pragma("unroll") for (int q = 0; q < 4; ++q) { O.w[q] = *(const LAS f32x4*)(ob + 0 * TC * 64 + (s_) * 64 + 4 * q); O.a[q] = *(const LAS f32x4*)(ob + 1 * TC * 64 + (s_) * 64 + 4 * q); \
        O.b[q] = *(const LAS f32x4*)(ob + 2 * TC * 64 + (s_) * 64 + 4 * q); O.k[q] = *(const LAS f32x4*)(ob + 3 * TC * 64 + (s_) * 64 + 4 * q); O.r[q] = *(const LAS f32x4*)(ob + 4 * TC * 64 + (s_) * 64 + 4 * q); } \
        O.v = *(const LAS f32x2*)(vb + (s_) * 64); } while (0)
#define SC_STEP(O, s_) do { float sa[2], y[2]; \
        _Pragma("unroll") for (int i = 0; i < 2; ++i) { f32x2 t = S2[i][0] * SC_PAIROF(O.a, 0); \
            _Pragma("unroll") for (int cp = 1; cp < 8; ++cp) t = S2[i][cp] * SC_PAIROF(O.a, cp) + t; \
            sa[i] = quad_sum(t.x + t.y); } \
        _Pragma("unroll") for (int i = 0; i < 2; ++i) { const f32x2 sav = (f32x2){sa[i], sa[i]}, vv = (f32x2){O.v[i], O.v[i]}; f32x2 t; \
            _Pragma("unroll") for (int cp = 0; cp < 8; ++cp) { f32x2 u = sav * SC_PAIROF(O.b, cp); u = vv * SC_PAIROF(O.k, cp) + u; S2[i][cp] = S2[i][cp] * SC_PAIROF(O.w, cp) + u; \
                t = (cp == 0) ? S2[i][0] * SC_PAIROF(O.r, 0) : S2[i][cp] * SC_PAIROF(O.r, cp) + t; } \
            y[i] = quad_sum(t.x + t.y); } \
        if (jg == 0) *(LAS f32x2*)(yb + (s_) * 64) = (f32x2){y[0], y[1]}; } while (0)
__device__ __forceinline__ void scan_phase(int tid, LAS unsigned char* lds, const bf16_t* R, const bf16_t* E, const bf16_t* Kb, const bf16_t* V, const bf16_t* AL, const bf16_t* G, const bf16_t* VFp, const bf16_t* SVp,
                                           const float* k_k, const float* k_a, const float* r_k, const float* lnw, const float* lnb, bf16_t* Z) {
    const int wave = __builtin_amdgcn_readfirstlane(tid >> 6), lane = tid & 63;
    const int role = (wave < 4) ? 0 : (wave < 6) ? 1 : 2, pi = (wave < 4) ? (wave >> 1) : (wave & 1), hf = wave & 1;
    LAS unsigned char* base = lds + pi * SC_PAIR;
    LAS float* OPS = (LAS float*)(base + SC_OPS); LAS float* VP = (LAS float*)(base + SC_VP); LAS float* BON = (LAS float*)(base + SC_BON); LAS float* YB = (LAS float*)(base + SC_YB);
    for (int pb = blockIdx.x * 2; pb < NB * 32; pb += gridDim.x * 2) {
        const int pair = pb + pi, b = pair >> 5, h = pair & 31;
        const size_t gbase = (size_t)b * SEQ * Dm + h * 64;
        const int st = lane >> 2, cgp = lane & 3;
        const int ig = lane >> 2, jg = lane & 3;
        if (role == 0) {
            f32x2 S2[2][8];
#pragma unroll
            for (int i = 0; i < 2; ++i)
#pragma unroll
                for (int c = 0; c < 8; ++c) S2[i][c] = (f32x2){0.f, 0.f};
            for (int it = 0; it < NCH + 2; ++it) {
                if (it >= 1 && it <= NCH) {
                    const int c_ = it - 1;
                    const LAS float* ob = OPS + (c_ & 1) * (5 * TC * 64) + 16 * jg;
                    const LAS float* vb = VP + (c_ % 3) * (TC * 64) + 32 * hf + 2 * ig;
                    LAS float* yb = YB + (c_ & 1) * (TC * 64) + 32 * hf + 2 * ig;
                    ScanOps OA, OB;
                    SC_LOAD(OA, 0);
#pragma unroll 1
                    for (int s = 0; s < TC; s += 2) {
                        SC_LOAD(OB, s + 1);
                        SC_STEP(OA, s);
                        if (s + 2 < TC) SC_LOAD(OA, s + 2);
                        SC_STEP(OB, s + 1);
                    }
                }
                __syncthreads();
            }
        } else if (role == 1) {
            float ckk[16], cka[16], crk[16];
            u32x4 raw[10];
#pragma unroll
            for (int c = 0; c < 16; ++c) { ckk[c] = k_k[h * 64 + 16 * cgp + c]; cka[c] = k_a[h * 64 + 16 * cgp + c]; crk[c] = r_k[h * 64 + 16 * cgp + c]; }
            const size_t go = gbase + (size_t)st * Dm + 16 * cgp;
            raw[0] = *(const u32x4*)(R + go); raw[1] = *(const u32x4*)(R + go + 8); raw[2] = *(const u32x4*)(Kb + go); raw[3] = *(const u32x4*)(Kb + go + 8);
            raw[4] = *(const u32x4*)(V + go); raw[5] = *(const u32x4*)(V + go + 8); raw[6] = *(const u32x4*)(E + go); raw[7] = *(const u32x4*)(E + go + 8);
            raw[8] = *(const u32x4*)(AL + go); raw[9] = *(const u32x4*)(AL + go + 8);
          for (int it = 0; it < NCH + 2; ++it) {
            if (it < NCH) {
                const unsigned rw[8] = {raw[0].x, raw[0].y, raw[0].z, raw[0].w, raw[1].x, raw[1].y, raw[1].z, raw[1].w}, kw[8] = {raw[2].x, raw[2].y, raw[2].z, raw[2].w, raw[3].x, raw[3].y, raw[3].z, raw[3].w};
                const unsigned vw[8] = {raw[4].x, raw[4].y, raw[4].z, raw[4].w, raw[5].x, raw[5].y, raw[5].z, raw[5].w}, ew[8] = {raw[6].x, raw[6].y, raw[6].z, raw[6].w, raw[7].x, raw[7].y, raw[7].z, raw[7].w};
                const unsigned aw[8] = {raw[8].x, raw[8].y, raw[8].z, raw[8].w, raw[9].x, raw[9].y, raw[9].z, raw[9].w};
                float rr[16], kk[16], vv[16], ww[16], lr[16], kn[16];
#pragma unroll
                for (int j = 0; j < 8; ++j) { rr[2 * j] = bf_lo(rw[j]); rr[2 * j + 1] = bf_hi(rw[j]); kk[2 * j] = bf_lo(kw[j]); kk[2 * j + 1] = bf_hi(kw[j]);
                    vv[2 * j] = bf_lo(vw[j]); vv[2 * j + 1] = bf_hi(vw[j]); ww[2 * j] = __expf(-h_lo(ew[j])); ww[2 * j + 1] = __expf(-h_hi(ew[j]));
                    lr[2 * j] = h_lo(aw[j]); lr[2 * j + 1] = h_hi(aw[j]); }
                if (SVp) {
                    const size_t gv = gbase + (size_t)(it * TC + st) * Dm + 16 * cgp;
                    const u32x4 f0 = *(const u32x4*)(VFp + gv), f1 = *(const u32x4*)(VFp + gv + 8), s0 = *(const u32x4*)(SVp + gv), s1 = *(const u32x4*)(SVp + gv + 8);
                    const unsigned fw[8] = {f0.x, f0.y, f0.z, f0.w, f1.x, f1.y, f1.z, f1.w}, sw[8] = {s0.x, s0.y, s0.z, s0.w, s1.x, s1.y, s1.z, s1.w};
#pragma unroll
                    for (int j = 0; j < 8; ++j) { vv[2 * j] += (bf_lo(fw[j]) - vv[2 * j]) * h_lo(sw[j]); vv[2 * j + 1] += (bf_hi(fw[j]) - vv[2 * j + 1]) * h_hi(sw[j]); }
                }
                if (it + 1 < NCH) {
                    const size_t go = gbase + (size_t)((it + 1) * TC + st) * Dm + 16 * cgp;
                    raw[0] = *(const u32x4*)(R + go); raw[1] = *(const u32x4*)(R + go + 8); raw[2] = *(const u32x4*)(Kb + go); raw[3] = *(const u32x4*)(Kb + go + 8);
                    raw[4] = *(const u32x4*)(V + go); raw[5] = *(const u32x4*)(V + go + 8); raw[6] = *(const u32x4*)(E + go); raw[7] = *(const u32x4*)(E + go + 8);
                    raw[8] = *(const u32x4*)(AL + go); raw[9] = *(const u32x4*)(AL + go + 8);
                }
                float ss = 0.f;
#pragma unroll
                for (int c = 0; c < 16; ++c) { kn[c] = kk[c] * ckk[c]; ss += kn[c] * kn[c]; }
                ss = quad_sum(ss);
                const float inv = 1.f / fmaxf(sqrtf(ss), 1e-12f);
                float bon = 0.f; float av[16], bv[16], kp[16];
#pragma unroll
                for (int c = 0; c < 16; ++c) { kn[c] *= inv; av[c] = -kn[c]; bv[c] = kn[c] * lr[c]; kp[c] = kk[c] * (1.f + (lr[c] - 1.f) * cka[c]); bon += rr[c] * kp[c] * crk[c]; }
                bon = quad_sum(bon);
                LAS float* ob = OPS + (it & 1) * (5 * TC * 64) + st * 64 + 16 * cgp;
#pragma unroll
                for (int q = 0; q < 4; ++q) {
                    *(LAS f32x4*)(ob + 0 * TC * 64 + 4 * q) = (f32x4){ww[4 * q], ww[4 * q + 1], ww[4 * q + 2], ww[4 * q + 3]};
                    *(LAS f32x4*)(ob + 1 * TC * 64 + 4 * q) = (f32x4){av[4 * q], av[4 * q + 1], av[4 * q + 2], av[4 * q + 3]};
                    *(LAS f32x4*)(ob + 2 * TC * 64 + 4 * q) = (f32x4){bv[4 * q], bv[4 * q + 1], bv[4 * q + 2], bv[4 * q + 3]};
                    *(LAS f32x4*)(ob + 3 * TC * 64 + 4 * q) = (f32x4){kp[4 * q], kp[4 * q + 1], kp[4 * q + 2], kp[4 * q + 3]};
                    *(LAS f32x4*)(ob + 4 * TC * 64 + 4 * q) = (f32x4){rr[4 * q], rr[4 * q + 1], rr[4 * q + 2], rr[4 * q + 3]};
                    *(LAS f32x4*)(VP + (it % 3) * (TC * 64) + st * 64 + 16 * cgp + 4 * q) = (f32x4){vv[4 * q], vv[4 * q + 1], vv[4 * q + 2], vv[4 * q + 3]};
                }
                if (cgp == 0) BON[(it % 3) * TC + st] = bon;
            }
            __syncthreads();
          }
        } else {
            float ckk[16], cka[16];
#pragma unroll
            for (int c = 0; c < 16; ++c) { ckk[c] = lnw[h * 64 + 16 * cgp + c]; cka[c] = lnb[h * 64 + 16 * cgp + c]; }
          for (int it = 0; it < NCH + 2; ++it) {
            if (it >= 2) {
                const int c_ = it - 2;
                const size_t go = gbase + (size_t)(c_ * TC + st) * Dm + 16 * cgp;
                const u32x4 g0 = *(const u32x4*)(G + go), g1 = *(const u32x4*)(G + go + 8);
                const LAS float* yb = YB + (c_ & 1) * (TC * 64) + st * 64 + 16 * cgp;
                const LAS float* vb = VP + (c_ % 3) * (TC * 64) + st * 64 + 16 * cgp;
                float y[16], vv[16];
#pragma unroll
                for (int q = 0; q < 4; ++q) { const f32x4 t = *(const LAS f32x4*)(yb + 4 * q), u = *(const LAS f32x4*)(vb + 4 * q);
                    y[4 * q] = t.x; y[4 * q + 1] = t.y; y[4 * q + 2] = t.z; y[4 * q + 3] = t.w; vv[4 * q] = u.x; vv[4 * q + 1] = u.y; vv[4 * q + 2] = u.z; vv[4 * q + 3] = u.w; }
                const float bon = BON[(c_ % 3) * TC + st];
                float s = 0.f;
#pragma unroll
                for (int c = 0; c < 16; ++c) s += y[c];
                const float mean = quad_sum(s) * (1.f / 64.f);
                float s2 = 0.f;
#pragma unroll
                for (int c = 0; c < 16; ++c) { y[c] -= mean; s2 += y[c] * y[c]; }
                const float rstd = rsqrtf(quad_sum(s2) * (1.f / 64.f) + LN_EPS);
                const unsigned gw_[8] = {g0.x, g0.y, g0.z, g0.w, g1.x, g1.y, g1.z, g1.w}; unsigned ow[8];
#pragma unroll
                for (int j = 0; j < 8; ++j) {
                    const float z0 = (y[2 * j] * rstd * ckk[2 * j] + cka[2 * j] + bon * vv[2 * j]) * siluf_(bf_lo(gw_[j]));
                    const float z1 = (y[2 * j + 1] * rstd * ckk[2 * j + 1] + cka[2 * j + 1] + bon * vv[2 * j + 1]) * siluf_(bf_hi(gw_[j]));
                    ow[j] = pk2(z0, z1); }
                *(u32x4*)(Z + go) = (u32x4){ow[0], ow[1], ow[2], ow[3]}; *(u32x4*)(Z + go + 8) = (u32x4){ow[4], ow[5], ow[6], ow[7]};
            }
            __syncthreads();
          }
        }
    }
}
__device__ __forceinline__ void attn_weights(int tid, const Params& p, LAS unsigned char* lds) {
    bf16_t* Wt = (bf16_t*)(p.ws + WS_W);
    TrJob jobs[2];
    jobs[0] = TrJob{p.in[20], Dm, 10240, 10240, Wt, Dm};
    jobs[1] = TrJob{p.in[23], 1024, Dm, Dm, Wt + (size_t)10240 * 2048, 1024};
    run_transposes<2>(tid, jobs, lds);
    float* COS = (float*)(p.ws + WS_COS); float* SIN = (float*)(p.ws + WS_SIN);
    const long gt = (long)blockIdx.x * NTHR + tid, GT = (long)gridDim.x * NTHR;
    for (long i = gt; i < (long)T * 16; i += GT) {
        const int t = (int)(i >> 4), f = (int)(i & 15);
        const float inv = powf(500000.0f, -(float)(2 * f) / 32.0f);
        const float ang = (float)p.positions[t] * inv; float s, c; sincosf(ang, &s, &c);
        COS[i] = c; SIN[i] = s;
    }
}
__device__ __forceinline__ void pool_weights(int tid, const Params& p, LAS unsigned char* lds) {
    bf16_t* Wt = (bf16_t*)(p.ws + WS_W);
    TrJob jobs[6];
    jobs[0] = TrJob{p.in[24], Dm, 4096, 4096, Wt, Dm};
#pragma unroll
    for (int g = 0; g < 4; ++g) jobs[1 + g] = TrJob{p.in[25] + (size_t)g * 512 * 512, 512, 512, 512, Wt + (size_t)4096 * 2048 + (size_t)g * 512 * 512, 512};
    jobs[5] = TrJob{p.in[27], Dm, Dm, Dm, Wt + (size_t)4096 * 2048 + (size_t)2048 * 512, Dm};
    run_transposes<6>(tid, jobs, lds);
}

__device__ __forceinline__ unsigned off_b(unsigned row, unsigned ch) { return 256u * row + 16u * (ch ^ (((row & 3) << 2) | ((row >> 2) & 3))); }
__device__ __forceinline__ void attn_phase(int tid, LAS unsigned char* lds, bf16_t* QKVG, float* LSE, const float* qn_w, const float* kn_w, const float* COS, const float* SIN) {
    const int w = __builtin_amdgcn_readfirstlane(tid >> 6), lane = tid & 63, fr = lane & 15, g4 = lane >> 4;
    LAS unsigned char* Kt = lds; LAS unsigned char* Vt = lds + 65536;
    const float scale = 0.08838834764831845f;
    for (int item = blockIdx.x; item < NB * 8 * 48; item += gridDim.x) {
        const int bh = item / 48, r = item % 48, b = bh >> 3, hh = bh & 7;
        int g, dil, rho, n;
        if (r < 16) { g = 0; dil = 1; rho = 0; n = r; } else if (r < 32) { g = 1; dil = 4; rho = (r - 16) >> 2; n = (r - 16) & 3; } else { g = 2; dil = 16; rho = r - 32; n = 0; }
        const int qcol = (g * 8 + hh) * 128, kcol = 3072 + qcol, vcol = 6144 + qcol;
        const size_t tok0 = (size_t)b * SEQ + rho;
        __syncthreads();
        {
            const int ch = tid & 15; const float sgk = (ch < 2) ? -1.f : 1.f;
            const f32x4 kw0 = *(const f32x4*)(kn_w + g * 128 + ch * 8), kw1 = *(const f32x4*)(kn_w + g * 128 + ch * 8 + 4);
            const float kwv[8] = {kw0.x, kw0.y, kw0.z, kw0.w, kw1.x, kw1.y, kw1.z, kw1.w};
#pragma unroll
            for (int ih = 0; ih < 2; ++ih) {
                u32x4 kv[4], vv[4]; f32x4 cs[4][4];
#pragma unroll
                for (int i2 = 0; i2 < 4; ++i2) {
                    const int row = (tid >> 4) + 32 * (4 * ih + i2), s = 128 * (n - 1) + row;
                    kv[i2] = (u32x4){0u, 0u, 0u, 0u}; vv[i2] = kv[i2];
#pragma unroll
                    for (int q = 0; q < 4; ++q) cs[i2][q] = (f32x4){0.f, 0.f, 0.f, 0.f};
                    if (s >= 0) { const size_t tk = tok0 + (size_t)dil * s; const bf16_t* src = QKVG + tk * 10240 + ch * 8; kv[i2] = *(const u32x4*)(src + kcol); vv[i2] = *(const u32x4*)(src + vcol);
                        if (ch < 4) { const float* cp = COS + tk * 16 + (ch & 1) * 8; const float* sp = SIN + tk * 16 + (ch & 1) * 8;
                            cs[i2][0] = *(const f32x4*)cp; cs[i2][1] = *(const f32x4*)(cp + 4); cs[i2][2] = *(const f32x4*)sp; cs[i2][3] = *(const f32x4*)(sp + 4); } }
                }
#pragma unroll
                for (int i2 = 0; i2 < 4; ++i2) {
                    const int row = (tid >> 4) + 32 * (4 * ih + i2);
                    const unsigned rw[4] = {kv[i2].x, kv[i2].y, kv[i2].z, kv[i2].w};
                    float x[8]; float ss = 0.f;
#pragma unroll
                    for (int j = 0; j < 4; ++j) { x[2 * j] = bf_lo(rw[j]); x[2 * j + 1] = bf_hi(rw[j]); ss += x[2 * j] * x[2 * j] + x[2 * j + 1] * x[2 * j + 1]; }
                    const float rstd = rsqrtf(row16_sum(ss) * (1.f / 128.f) + RMS_EPS);
                    const float cv[8] = {cs[i2][0].x, cs[i2][0].y, cs[i2][0].z, cs[i2][0].w, cs[i2][1].x, cs[i2][1].y, cs[i2][1].z, cs[i2][1].w};
                    const float sv[8] = {cs[i2][2].x, cs[i2][2].y, cs[i2][2].z, cs[i2][2].w, cs[i2][3].x, cs[i2][3].y, cs[i2][3].z, cs[i2][3].w};
#pragma unroll
                    for (int j = 0; j < 8; ++j) { x[j] = x[j] * rstd * kwv[j];
                        const float px = __int_as_float(__builtin_amdgcn_update_dpp(0, __float_as_int(x[j]), 0x4E, 0xF, 0xF, true));
                        x[j] = (ch < 4) ? x[j] * cv[j] + sgk * px * sv[j] : x[j]; }
                    u32x4 ko; ko.x = pk2(x[0], x[1]); ko.y = pk2(x[2], x[3]); ko.z = pk2(x[4], x[5]); ko.w = pk2(x[6], x[7]);
                    *(LAS u32x4*)(Kt + off_b(row, ch)) = ko; *(LAS u32x4*)(Vt + off_b(row, ch)) = vv[i2];
                }
            }
        }
        const size_t qtok = tok0 + (size_t)dil * (128 * n + 16 * w + fr);
        bf16x8 qf[4];
        {
            u32x4 qr[4]; f32x4 qw[4][2];
#pragma unroll
            for (int ks = 0; ks < 4; ++ks) { qr[ks] = *(const u32x4*)(QKVG + qtok * 10240 + qcol + 32 * ks + 8 * g4);
                qw[ks][0] = *(const f32x4*)(qn_w + g * 128 + 32 * ks + 8 * g4); qw[ks][1] = *(const f32x4*)(qn_w + g * 128 + 32 * ks + 8 * g4 + 4); }
            const float* cp = COS + qtok * 16 + (g4 & 1) * 8; const float* sp = SIN + qtok * 16 + (g4 & 1) * 8;
            const f32x4 c0 = *(const f32x4*)cp, c1 = *(const f32x4*)(cp + 4), s0 = *(const f32x4*)sp, s1 = *(const f32x4*)(sp + 4);
            float x[4][8]; float ss = 0.f;
#pragma unroll
            for (int ks = 0; ks < 4; ++ks) { const unsigned rw[4] = {qr[ks].x, qr[ks].y, qr[ks].z, qr[ks].w};
#pragma unroll
                for (int j = 0; j < 4; ++j) { x[ks][2 * j] = bf_lo(rw[j]); x[ks][2 * j + 1] = bf_hi(rw[j]); ss += x[ks][2 * j] * x[ks][2 * j] + x[ks][2 * j + 1] * x[ks][2 * j + 1]; } }
            ss += __shfl_xor(ss, 16); ss += __shfl_xor(ss, 32);
            const float rstd = rsqrtf(ss * (1.f / 128.f) + RMS_EPS);
#pragma unroll
            for (int ks = 0; ks < 4; ++ks)
#pragma unroll
                for (int j = 0; j < 8; ++j) x[ks][j] = x[ks][j] * rstd * qw[ks][j >> 2][j & 3];
            const float cv[8] = {c0.x, c0.y, c0.z, c0.w, c1.x, c1.y, c1.z, c1.w}, sv[8] = {s0.x, s0.y, s0.z, s0.w, s1.x, s1.y, s1.z, s1.w};
            const float sgq = (g4 < 2) ? -1.f : 1.f;
#pragma unroll
            for (int j = 0; j < 8; ++j) { const float px = __shfl_xor(x[0][j], 32); x[0][j] = x[0][j] * cv[j] + sgq * px * sv[j]; }
#pragma unroll
            for (int ks = 0; ks < 4; ++ks) { u32x4 t; t.x = pk2(x[ks][0], x[ks][1]); t.y = pk2(x[ks][2], x[ks][3]); t.z = pk2(x[ks][4], x[ks][5]); t.w = pk2(x[ks][6], x[ks][7]); qf[ks] = __builtin_bit_cast(bf16x8, t); }
        }
        __syncthreads();
        f32x4 sacc[9];
#pragma unroll
        for (int kbi = 0; kbi < 9; ++kbi) { sacc[kbi] = (f32x4){0.f, 0.f, 0.f, 0.f};
#pragma unroll
            for (int ks = 0; ks < 4; ++ks) { const bf16x8 kf = *(const LAS bf16x8*)(Kt + off_b(16 * (w + kbi) + fr, 4 * ks + g4));
                sacc[kbi] = __builtin_amdgcn_mfma_f32_16x16x32_bf16(kf, qf[ks], sacc[kbi], 0, 0, 0); } }
        const int qi = 16 * w + fr;
        float mx = -3.0e38f;
#pragma unroll
        for (int kbi = 0; kbi < 9; ++kbi)
#pragma unroll
            for (int j = 0; j < 4; ++j) { const int kj = 16 * (w + kbi) + 4 * g4 + j; const bool ok = (kj >= qi) && (kj <= qi + 128) && (n > 0 || kj >= 128);
                const float sv = ok ? sacc[kbi][j] * scale : -3.0e38f; sacc[kbi][j] = sv; mx = fmaxf(mx, sv); }
        mx = fmaxf(mx, __shfl_xor(mx, 16)); mx = fmaxf(mx, __shfl_xor(mx, 32));
        float l = 0.f;
#pragma unroll
        for (int kbi = 0; kbi < 9; ++kbi)
#pragma unroll
            for (int j = 0; j < 4; ++j) { const float pv = (sacc[kbi][j] > -1.0e38f) ? __expf(sacc[kbi][j] - mx) : 0.f; sacc[kbi][j] = pv; l += pv; }
        l += __shfl_xor(l, 16); l += __shfl_xor(l, 32);
        if (g4 == 0) LSE[((size_t)g * T + qtok) * 8 + hh] = mx + __logf(l);
        bf16x8 pb[5];
#pragma unroll
        for (int s5 = 0; s5 < 5; ++s5) { u32x4 t;
            t.x = pk2(sacc[2 * s5][0], sacc[2 * s5][1]); t.y = pk2(sacc[2 * s5][2], sacc[2 * s5][3]);
            if (s5 < 4) { t.z = pk2(sacc[2 * s5 + 1][0], sacc[2 * s5 + 1][1]); t.w = pk2(sacc[2 * s5 + 1][2], sacc[2 * s5 + 1][3]); } else { t.z = 0u; t.w = 0u; }
            pb[s5] = __builtin_bit_cast(bf16x8, t); }
        const float rl = 1.f / l;
        const unsigned q_ = fr >> 2, p_ = fr & 3;
        bf16_t* orow = QKVG + qtok * 10240 + qcol + 4 * g4;
#pragma unroll
        for (int c = 0; c < 8; ++c) {
            const unsigned vbase = (unsigned)(size_t)Vt + 256u * (16u * w + 4u * g4 + q_) + 16u * ((2u * c + (p_ >> 1)) ^ ((q_ << 2) | (unsigned)g4)) + 8u * (p_ & 1);
            u32x2 t0, t1, t2, t3, t4, t5, t6, t7, t8;
            asm volatile("ds_read_b64_tr_b16 %0, %9 offset:0\n\tds_read_b64_tr_b16 %1, %9 offset:4096\n\tds_read_b64_tr_b16 %2, %9 offset:8192\n\t"
                         "ds_read_b64_tr_b16 %3, %9 offset:12288\n\tds_read_b64_tr_b16 %4, %9 offset:16384\n\tds_read_b64_tr_b16 %5, %9 offset:20480\n\t"
                         "ds_read_b64_tr_b16 %6, %9 offset:24576\n\tds_read_b64_tr_b16 %7, %9 offset:28672\n\tds_read_b64_tr_b16 %8, %9 offset:32768\n\t"
                         "s_waitcnt lgkmcnt(0)"
                         : "=&v"(t0), "=&v"(t1), "=&v"(t2), "=&v"(t3), "=&v"(t4), "=&v"(t5), "=&v"(t6), "=&v"(t7), "=&v"(t8) : "v"(vbase) : "memory");
            f32x4 oacc = (f32x4){0.f, 0.f, 0.f, 0.f};
            oacc = __builtin_amdgcn_mfma_f32_16x16x32_bf16(__builtin_bit_cast(bf16x8, (u32x4){t0.x, t0.y, t1.x, t1.y}), pb[0], oacc, 0, 0, 0);
            oacc = __builtin_amdgcn_mfma_f32_16x16x32_bf16(__builtin_bit_cast(bf16x8, (u32x4){t2.x, t2.y, t3.x, t3.y}), pb[1], oacc, 0, 0, 0);
            oacc = __builtin_amdgcn_mfma_f32_16x16x32_bf16(__builtin_bit_cast(bf16x8, (u32x4){t4.x, t4.y, t5.x, t5.y}), pb[2], oacc, 0, 0, 0);
            oacc = __builtin_amdgcn_mfma_f32_16x16x32_bf16(__builtin_bit_cast(bf16x8, (u32x4){t6.x, t6.y, t7.x, t7.y}), pb[3], oacc, 0, 0, 0);
            oacc = __builtin_amdgcn_mfma_f32_16x16x32_bf16(__builtin_bit_cast(bf16x8, (u32x4){t8.x, t8.y, t8.x, t8.y}), pb[4], oacc, 0, 0, 0);
            u32x2 o; o.x = pk2(oacc[0] * rl, oacc[1] * rl); o.y = pk2(oacc[2] * rl, oacc[3] * rl);
            *(u32x2*)(orow + 16 * c) = o;
        }
    }
}
__device__ __forceinline__ void attn_combine_phase(int tid, const bf16_t* QKVG, const float* LSE, bf16_t* Z) {
    const long gt = (long)blockIdx.x * NTHR + tid, GT = (long)gridDim.x * NTHR;
    for (long i = gt; i < (long)T * 128; i += GT) {
        const size_t t = (size_t)(i >> 7); const int hh = (int)((i >> 4) & 7), d8 = (int)(i & 15);
        const float l0 = LSE[((size_t)0 * T + t) * 8 + hh], l1 = LSE[((size_t)1 * T + t) * 8 + hh], l2 = LSE[((size_t)2 * T + t) * 8 + hh];
        const float mx = fmaxf(l0, fmaxf(l1, l2)); float w0 = __expf(l0 - mx), w1 = __expf(l1 - mx), w2 = __expf(l2 - mx); const float rs = 1.f / (w0 + w1 + w2); w0 *= rs; w1 *= rs; w2 *= rs;
        const bf16_t* row = QKVG + t * 10240 + hh * 128 + d8 * 8;
        const u32x4 o0 = *(const u32x4*)row, o1 = *(const u32x4*)(row + 1024), o2 = *(const u32x4*)(row + 2048), gg = *(const u32x4*)(row + 9216);
        const unsigned a0[4] = {o0.x, o0.y, o0.z, o0.w}, a1[4] = {o1.x, o1.y, o1.z, o1.w}, a2[4] = {o2.x, o2.y, o2.z, o2.w}, ga[4] = {gg.x, gg.y, gg.z, gg.w}; unsigned ow[4];
#pragma unroll
        for (int j = 0; j < 4; ++j) {
            const float lo = (w0 * bf_lo(a0[j]) + w1 * bf_lo(a1[j]) + w2 * bf_lo(a2[j])) * siluf_(bf_lo(ga[j]));
            const float hi = (w0 * bf_hi(a0[j]) + w1 * bf_hi(a1[j]) + w2 * bf_hi(a2[j])) * siluf_(bf_hi(ga[j]));
            ow[j] = pk2(lo, hi); }
        *(u32x4*)(Z + t * 1024 + hh * 128 + d8 * 8) = (u32x4){ow[0], ow[1], ow[2], ow[3]};
    }
}
__device__ __forceinline__ void pool_diff_phase(int tid, const bf16_t* UG, bf16_t* DIFF) {
    const long gt = (long)blockIdx.x * NTHR + tid, GT = (long)gridDim.x * NTHR;
    for (long i = gt; i < (long)NB * 32 * 256; i += GT) {
        const int c8 = (int)(i & 255), chunk = (int)((i >> 8) & 31), b = (int)(i >> 13);
        const int win = 2 << (c8 >> 6); const float rwin = 1.f / (float)win;
        const int t0 = chunk * 64;
        const bf16_t* ub = UG + (size_t)b * SEQ * 4096 + c8 * 8;
        float sum[8];
#pragma unroll
        for (int j = 0; j < 8; ++j) sum[j] = 0.f;
        for (int s = t0 - win + 1; s < t0; ++s) if (s >= 0) { const u32x4 v = *(const u32x4*)(ub + (size_t)s * 4096); const unsigned vw[4] = {v.x, v.y, v.z, v.w};
#pragma unroll
            for (int j = 0; j < 4; ++j) { sum[2 * j] += bf_lo(vw[j]); sum[2 * j + 1] += bf_hi(vw[j]); } }
        for (int t = t0; t < t0 + 64; ++t) {
            const u32x4 v = *(const u32x4*)(ub + (size_t)t * 4096); const unsigned vw[4] = {v.x, v.y, v.z, v.w};
            float u[8];
#pragma unroll
            for (int j = 0; j < 4; ++j) { u[2 * j] = bf_lo(vw[j]); u[2 * j + 1] = bf_hi(vw[j]); sum[2 * j] += u[2 * j]; sum[2 * j + 1] += u[2 * j + 1]; }
            const float rc = (t + 1 < win) ? 1.f / (float)(t + 1) : rwin;
            u32x4 o; o.x = pk2(sum[0] * rc - u[0], sum[1] * rc - u[1]); o.y = pk2(sum[2] * rc - u[2], sum[3] * rc - u[3]);
            o.z = pk2(sum[4] * rc - u[4], sum[5] * rc - u[5]); o.w = pk2(sum[6] * rc - u[6], sum[7] * rc - u[7]);
            *(u32x4*)(DIFF + ((size_t)b * SEQ + t) * Dm + c8 * 8) = o;
            if (t - win + 1 >= 0) { const u32x4 q = *(const u32x4*)(ub + (size_t)(t - win + 1) * 4096); const unsigned qw[4] = {q.x, q.y, q.z, q.w};
#pragma unroll
                for (int j = 0; j < 4; ++j) { sum[2 * j] -= bf_lo(qw[j]); sum[2 * j + 1] -= bf_hi(qw[j]); } }
        }
    }
}

#define XB_TMO      128
#define XB_XCNT(j)  (256  + 64 * (j))
#define XB_XSUB(j)  (1280 + 64 * (j))
#define XB_XGEN(j)  (2304 + 64 * (j))
#define XB_TOP      3328
#define XB_TOPGEN   3392
#define XCD_BAR_WORDS 3456
#define XB_SPIN_CAP (1u << 20)
__device__ __forceinline__ unsigned xb_ld(unsigned* p)              { return __hip_atomic_load(p, __ATOMIC_RELAXED, __HIP_MEMORY_SCOPE_AGENT); }
__device__ __forceinline__ unsigned xb_add(unsigned* p, unsigned v) { return __hip_atomic_fetch_add(p, v, __ATOMIC_RELAXED, __HIP_MEMORY_SCOPE_AGENT); }
__device__ __forceinline__ unsigned xb_xcc_id() { return (unsigned)__builtin_amdgcn_s_getreg((3 << 11) | 20) & 0xFu; }
#define XB_SPIN(cond, bar) do { unsigned _sp = 0; while (cond) { __builtin_amdgcn_s_sleep(1); \
    if ((++_sp & 255u) == 0u) { if (xb_ld(&(bar)[XB_TMO])) break; if (_sp > XB_SPIN_CAP) { atomicAdd(&(bar)[XB_TMO], 1u); break; } } } } while (0)
struct XcdBarrier { unsigned* bar; unsigned x; volatile LAS unsigned* st; };
__device__ __forceinline__ XcdBarrier xcd_barrier_post(unsigned* bar, volatile LAS unsigned* st) {
    XcdBarrier b; b.bar = bar; b.x = xb_xcc_id(); b.st = st;
    if (threadIdx.x == 0) (void)xb_add(&bar[XB_XCNT(b.x)], 1u);
    return b;
}
__device__ __forceinline__ void xcd_barrier_complete(unsigned* bar, unsigned x, unsigned& nloc, unsigned& nx) {
    const unsigned G = gridDim.x * gridDim.y * gridDim.z;
    unsigned sum, cnt, mine, sp = 0u;
    for (;;) {
        sum = 0u; cnt = 0u; mine = 0u;
#pragma unroll
        for (unsigned j = 0; j < 16; ++j) { const unsigned c = xb_ld(&bar[XB_XCNT(j)]); sum += c; cnt += (c > 0u) ? 1u : 0u; mine = (j == x) ? c : mine; }
        if (sum == G) break;
        __builtin_amdgcn_s_sleep(1);
        if ((++sp & 255u) == 0u) { if (xb_ld(&bar[XB_TMO])) break; if (sp > XB_SPIN_CAP) { atomicAdd(&bar[XB_TMO], 1u); break; } }
    }
    nloc = mine > 0u ? mine : 1u; nx = cnt > 0u ? cnt : 1u;
}
__device__ __forceinline__ void xcd_barrier(const XcdBarrier& b) {
    asm volatile("s_waitcnt vmcnt(0)" ::: "memory");
    __syncthreads();
    if (threadIdx.x == 0) {
        unsigned* bar = b.bar;
        __builtin_amdgcn_s_waitcnt(0);
        unsigned nloc = b.st[0], nx = b.st[1];
        if (nloc == 0u) { xcd_barrier_complete(bar, b.x, nloc, nx); b.st[0] = nloc; b.st[1] = nx; }
        const unsigned old = xb_add(&bar[XB_XSUB(b.x)], 1u);
        const unsigned gen = old / nloc;
        if (old + 1u == (gen + 1u) * nloc) {
            __builtin_amdgcn_fence(__ATOMIC_RELEASE, "agent");
            asm volatile("s_waitcnt vmcnt(0)" ::: "memory");
            const unsigned og = xb_add(&bar[XB_TOP], 1u);
            const unsigned tg = og / nx;
            if (og + 1u == (tg + 1u) * nx) xb_add(&bar[XB_TOPGEN], 1u);
            else XB_SPIN(xb_ld(&bar[XB_TOPGEN]) == tg, bar);
            __builtin_amdgcn_fence(__ATOMIC_ACQUIRE, "agent");
            xb_add(&bar[XB_XGEN(b.x)], 1u);
            asm volatile("s_waitcnt vmcnt(0)" ::: "memory");
        } else {
            XB_SPIN(xb_ld(&bar[XB_XGEN(b.x)]) == gen, bar);
            __builtin_amdgcn_fence(__ATOMIC_ACQUIRE, "agent");
            asm volatile("s_waitcnt vmcnt(0)" ::: "memory");
        }
    }
    __syncthreads();
}

__global__ void __launch_bounds__(NTHR) mega_fwd(Params p) {
    extern __shared__ __attribute__((aligned(16))) unsigned char lds_raw[];
    LAS unsigned char* lds = (LAS unsigned char*)lds_raw;
    cg::grid_group grid = cg::this_grid();
    const int ph_lo = p.ph_lo, ph_hi = p.ph_hi;
    volatile LAS unsigned* xst = (volatile LAS unsigned*)(lds + LDS_BYTES);
    if (threadIdx.x == 0) { xst[0] = 0u; xst[1] = 0u; }
    __syncthreads();
    const XcdBarrier xb = xcd_barrier_post((unsigned*)(p.ws + WS_BAR), xst);
    bool first_sync = true;
    int ph = 0;
#define RUN(ty, ...) do { if (ph >= ph_lo && ph < ph_hi) { { int tid = threadIdx.x; asm volatile("" : "+v"(tid)); __VA_ARGS__; } \
        if (ph + 1 < ph_hi) { if (first_sync) { grid.sync(); first_sync = false; } else xcd_barrier(xb); } } ++ph; } while (0)
    unsigned char* ws = p.ws;
    bf16_t* Wt = (bf16_t*)(ws + WS_W);
    bf16_t* LORA = (bf16_t*)(ws + WS_LORA);
    bf16_t* VF = (bf16_t*)(ws + WS_VF); bf16_t* B1 = (bf16_t*)(ws + WS_B1); bf16_t* B2 = (bf16_t*)(ws + WS_B2); bf16_t* B3 = (bf16_t*)(ws + WS_B3);
    bf16_t* B4 = (bf16_t*)(ws + WS_B4); bf16_t* M0 = (bf16_t*)(ws + WS_M0); bf16_t* M1 = (bf16_t*)(ws + WS_M1);
    for (int L = 0; L < 4; ++L) {
        const int kind = L % 3;
        bf16_t* XSA = (bf16_t*)p.out; bf16_t* XSB = XSA + (size_t)T * Dm;
        const void* xin = (L == 0) ? (const void*)p.in[0] : (L == 1) ? (const void*)XSA : (L == 2) ? (const void*)XSB : (const void*)M1;
        const float* nw = p.in[2] + (size_t)L * Dm;
        const bf16_t* oA; const bf16_t* oB; int olda, ont;
        if (kind == 0) {
            const int ia = L / 3; const bool has_v = ia > 0;
            const float* mu = p.in[3] + (size_t)ia * 6 * Dm;
            bf16_t* Vb = has_v ? B3 : VF;
            for (int rd = 0; rd < 2; ++rd) {
                RUN(0, if (rd == 0) rwkv_weights(tid, p, ia, has_v, lds);
                    if (L == 0) norm_mix_phase<3, false>(tid, xin, nw, mu + (size_t)(3 * rd) * Dm, mu + (size_t)(3 * rd + 1) * Dm, M0, XSA, mu + (size_t)(3 * rd + 2) * Dm, XSB);
                    else norm_mix_phase<3, true>(tid, xin, nw, mu + (size_t)(3 * rd) * Dm, mu + (size_t)(3 * rd + 1) * Dm, M0, XSA, mu + (size_t)(3 * rd + 2) * Dm, XSB));
                RUN(1, ProbRwkvIn pr; pr.nM = T / BM; pr.nN = (rd == 0) ? (has_v ? 25 : 24) : 10; pr.nt = Dm / BK; pr.lda = Dm; pr.ldb = Dm; pr.round = rd;
                    pr.A0 = M0; pr.dA1 = (long)(((const char*)XSA - (const char*)M0) / 2); pr.dA2 = (long)(((const char*)XSB - (const char*)M0) / 2); pr.Wt = Wt;
                    pr.O0 = B1; pr.dO1 = B2 - B1; pr.dO2 = Vb - B1; pr.dO3 = B4 - B1; pr.lora = LORA; gemm_phase(tid, lds, pr));
            }
            RUN(2, ProbRwkvUp pu; pu.nM = T / BM; pu.nN = has_v ? 24 : 16; pu.nt = 4; pu.lda = 256; pu.ldb = 256; pu.A = LORA; pu.Bt = Wt + (size_t)11008 * 2048;
                pu.w0 = p.in[5] + (size_t)ia * Dm; pu.d_a0 = (long)((p.in[8] + (size_t)ia * Dm) - pu.w0); pu.d_v0 = (long)(p.in[16] - pu.w0); pu.E = M0; pu.AL = XSA; pu.SV = XSB; gemm_phase(tid, lds, pu));
            RUN(3, scan_phase(tid, lds, B1, M0, B2, Vb, XSA, B4, has_v ? (const bf16_t*)VF : nullptr, has_v ? (const bf16_t*)XSB : nullptr, p.in[11] + (size_t)ia * Dm, p.in[12] + (size_t)ia * Dm, p.in[13] + (size_t)ia * Dm, p.in[14] + (size_t)ia * Dm, p.in[15] + (size_t)ia * Dm, B1));
            oA = B1; oB = Wt + (size_t)8192 * 2048; olda = Dm; ont = Dm / BK;
        } else {
            RUN(4, if (kind == 1) attn_weights(tid, p, lds); else pool_weights(tid, p, lds); norm_mix_phase<0, true>(tid, xin, nw, nullptr, nullptr, M1, nullptr));
            RUN(5, ProbStoreBf16 ps; ps.nM = T / BM; ps.nN = (kind == 1) ? 40 : 16; ps.nt = Dm / BK; ps.lda = Dm; ps.ldb = Dm; ps.A = M1; ps.Bt = Wt; ps.O = B1; ps.ldo = (kind == 1) ? 10240 : 4096; gemm_phase(tid, lds, ps));
            if (kind == 1) {
                RUN(7, attn_phase(tid, lds, B1, (float*)(ws + WS_LSE), p.in[21], p.in[22], (const float*)(ws + WS_COS), (const float*)(ws + WS_SIN)));
                RUN(8, attn_combine_phase(tid, B1, (const float*)(ws + WS_LSE), M1));
                oA = M1; oB = Wt + (size_t)10240 * 2048; olda = 1024; ont = 1024 / BK;
            } else {
                RUN(9, pool_diff_phase(tid, B1, B3));
                RUN(10, ProbPoolGrp pg; pg.nM = T / BM; pg.nN = 8; pg.nt = 512 / BK; pg.lda = Dm; pg.ldb = 512; pg.A = B3; pg.Bt = Wt + (size_t)4096 * 2048; pg.scale = p.in[26]; pg.UG = B1; pg.Z = B4; gemm_phase(tid, lds, pg));
                oA = B4; oB = Wt + (size_t)4096 * 2048 + (size_t)2048 * 512; olda = Dm; ont = Dm / BK;
            }
        }
        RUN(11, ProbResid po; po.nM = T / BM; po.nN = 8; po.nt = ont; po.lda = olda; po.ldb = olda; po.A = oA; po.Bt = oB; po.xin = xin; po.in_bf = (L != 0); po.xout = (L == 0) ? (void*)XSA : (L == 1) ? (void*)XSB : (L == 2) ? (void*)M1 : (void*)p.out; po.out_bf = (L != 3); gemm_phase(tid, lds, po));
    }
#undef RUN
}
constexpr int N_PHASES = 7 + 5 + 5 + 7;

extern "C" void kernel_launch(void* const* d_in, const int* in_sizes, int n_in, void* d_out, int out_size, void* d_ws, size_t ws_size, hipStream_t stream) {
    static int grid = 0;
    if (grid == 0) {
        if (n_in != 28 || ws_size < WS_END) { fprintf(stderr, "kernel_launch: unexpected n_in %d / ws_size %zu\n", n_in, ws_size); grid = -1; return; }
        int dev = 0, cus = 0, per_cu = 0;
        hipGetDevice(&dev); hipDeviceGetAttribute(&cus, hipDeviceAttributeMultiprocessorCount, dev);
        if (hipFuncSetAttribute((const void*)mega_fwd, hipFuncAttributeMaxDynamicSharedMemorySize, LDS_BYTES + 64) != hipSuccess) { fprintf(stderr, "kernel_launch: hipFuncSetAttribute failed\n"); grid = -1; return; }
        if (hipOccupancyMaxActiveBlocksPerMultiprocessor(&per_cu, (const void*)mega_fwd, NTHR, LDS_BYTES + 64) != hipSuccess || per_cu < 1) { fprintf(stderr, "kernel_launch: occupancy query failed (%d)\n", per_cu); per_cu = 1; }
        (void)hipGetLastError();
        grid = cus;
    }
    if (grid < 0) return;
    if (hipMemsetAsync((unsigned char*)d_ws + WS_BAR, 0, XCD_BAR_WORDS * 4, stream) != hipSuccess) { fprintf(stderr, "kernel_launch: memset failed\n"); return; }
    Params p{};
    for (int i = 0; i < 28; ++i) p.in[i] = (const float*)d_in[i];
    p.positions = (const int*)d_in[1]; p.out = (float*)d_out; p.ws = (unsigned char*)d_ws;
#if MK_MULTI
    for (int k = 0; k < N_PHASES; ++k) { p.ph_lo = k; p.ph_hi = k + 1; hipLaunchKernelGGL(mega_fwd, dim3(grid), dim3(NTHR), LDS_BYTES + 64, stream, p); }
#else
    p.ph_lo = 0; p.ph_hi = N_PHASES;
    void* args[] = {&p};
    hipError_t e = hipLaunchCooperativeKernel((const void*)mega_fwd, dim3(grid), dim3(NTHR), args, LDS_BYTES + 64, stream);
    if (e != hipSuccess) fprintf(stderr, "cooperative launch failed: %s (grid %d)\n", hipGetErrorString(e), grid);
#endif
}
```
